# Optimizing an MI355X kernel written in HIP

```python
import math
import jax
import jax.numpy as jnp
from jax import lax
import numpy as np


D_MODEL = 2048
BATCH = 1
SEQ = 8192
DEPTH = 4

N_MIXERS = 4
N_HEADS = 16
HEAD_DIM = D_MODEL // N_HEADS
ROPE_THETA = 500000.0
ROPE_FRACTION = 4
Q_BLOCK = 128
RMS_EPS = 1e-6
FFN_HIDDEN = ((8 * D_MODEL + 3 * 256 - 1) // (3 * 256)) * 256
MLA_Q_LORA = D_MODEL // 4
MLA_KV_LORA = D_MODEL // 4
MLA_NOPE = HEAD_DIM
MLA_ROPE = HEAD_DIM // 2
MLA_V = HEAD_DIM
IDX_HEADS = 16
IDX_DIM = 64
IDX_TOPK = 256
DIFF_HEADS = N_HEADS
DIFF_DIM = HEAD_DIM // 2
POS_OFFSET_MAX = 1024

kernel_name = 'hybrid_mla_dsa_diff_fox_trunk'


def _rms_norm(x, g):
    xf = x.astype(jnp.float32)
    y = xf * lax.rsqrt(jnp.mean(xf * xf, axis=-1, keepdims=True) + RMS_EPS)
    return (y * g.astype(jnp.float32)).astype(x.dtype)


def _rope_cos_sin(positions, rot_dim):
    inv_freq = ROPE_THETA ** (-jnp.arange(0, rot_dim, 2, dtype=jnp.float32) / rot_dim)
    ang = positions.astype(jnp.float32)[..., None] * inv_freq
    return jnp.cos(ang)[:, None], jnp.sin(ang)[:, None]


def _apply_rope(x, cos, sin):
    half = cos.shape[-1]
    x1 = x[..., :half].astype(jnp.float32)
    x2 = x[..., half:2 * half].astype(jnp.float32)
    rotated = jnp.concatenate([x1 * cos - x2 * sin, x2 * cos + x1 * sin], axis=-1).astype(x.dtype)
    return jnp.concatenate([rotated, x[..., 2 * half:]], axis=-1)


def _split_heads(t, n_heads):
    b, s, _ = t.shape
    return t.reshape(b, s, n_heads, -1).transpose(0, 2, 1, 3)


def _merge_heads(t):
    b, h, s, d = t.shape
    return t.transpose(0, 2, 1, 3).reshape(b, s, h * d)


def _causal_mask(start, n_q, n_k):
    q_pos = start + jnp.arange(n_q)
    return q_pos[:, None] >= jnp.arange(n_k)[None, :]


def _sweep_query_blocks(block_fn, q_side):
    s = q_side[0].shape[2]
    nb = s // Q_BLOCK

    def split(a):
        a = a.reshape(a.shape[:2] + (nb, Q_BLOCK) + a.shape[3:])
        return jnp.moveaxis(a, 2, 0)

    starts = jnp.arange(nb, dtype=jnp.int32) * Q_BLOCK
    out = lax.map(lambda xs: block_fn(xs[0], *xs[1]), (starts, tuple(split(a) for a in q_side)))
    out = jnp.moveaxis(out, 0, 2)
    return out.reshape(out.shape[:2] + (nb * Q_BLOCK,) + out.shape[4:])


def _dense_causal_attention(q, k, v, scale):
    s = k.shape[2]

    def block(start, qb):
        logits = jnp.einsum('bhqd,bhkd->bhqk', qb, k).astype(jnp.float32) * scale
        logits = jnp.where(_causal_mask(start, Q_BLOCK, s), logits, -jnp.inf)
        p = jax.nn.softmax(logits, axis=-1)
        return jnp.einsum('bhqk,bhkd->bhqd', p.astype(v.dtype), v)

    return _sweep_query_blocks(block, (q,))


def _mla_mixer(h, rope_mla, w_in, q_a_g, kv_a_g, w_q_b, w_kv_b, q_g, k_g, w_out):
    b, s, _ = h.shape
    c_q, c_kv, k_pe = jnp.split(h @ w_in, [MLA_Q_LORA, MLA_Q_LORA + MLA_KV_LORA], axis=-1)
    q = _split_heads(_rms_norm(c_q, q_a_g) @ w_q_b, N_HEADS)
    kv = _split_heads(_rms_norm(c_kv, kv_a_g) @ w_kv_b, N_HEADS)
    k_nope, v = jnp.split(kv, [MLA_NOPE], axis=-1)
    k_pe = jnp.broadcast_to(k_pe[:, None], (b, N_HEADS, s, MLA_ROPE))
    k = jnp.concatenate([k_pe, k_nope], axis=-1)
    cos, sin = rope_mla
    q = _apply_rope(_rms_norm(q, q_g), cos, sin)
    k = _apply_rope(_rms_norm(k, k_g), cos, sin)
    o = _dense_causal_attention(q, k, v, (MLA_ROPE + MLA_NOPE) ** -0.5)
    return _merge_heads(o) @ w_out


def _dsa_mixer(h, rope_head, rope_idx, w_in, q_g, k_g, idx_k_g, w_out):
    b, s, _ = h.shape
    hd = N_HEADS * HEAD_DIM
    ih = IDX_HEADS * IDX_DIM
    q, k, v, iq, ik, iw = jnp.split(h @ w_in, [hd, 2 * hd, 3 * hd, 3 * hd + ih, 3 * hd + ih + IDX_DIM], axis=-1)
    cos, sin = rope_head
    q = _apply_rope(_rms_norm(_split_heads(q, N_HEADS), q_g), cos, sin)
    k = _apply_rope(_rms_norm(_split_heads(k, N_HEADS), k_g), cos, sin)
    v = _split_heads(v, N_HEADS)
    icos, isin = rope_idx
    iq = _apply_rope(_split_heads(iq, IDX_HEADS), icos, isin)
    ik = _apply_rope(_rms_norm(ik, idx_k_g)[:, None], icos, isin)[:, 0]
    iw = (iw.astype(jnp.float32) * IDX_HEADS ** -0.5).transpose(0, 2, 1)
    n_sel = min(IDX_TOPK, s // 4)
    scale = HEAD_DIM ** -0.5
    iscale = IDX_DIM ** -0.5
    take = jax.vmap(lambda t, idx: t[:, idx])

    def block(start, qb, iqb, iwb):
        q_pos = start + jnp.arange(Q_BLOCK)
        rel = jax.nn.relu(jnp.einsum('bhqd,bkd->bhqk', iqb, ik).astype(jnp.float32) * iscale)
        score = jnp.einsum('bhq,bhqk->bqk', iwb, rel)
        score = jnp.where(_causal_mask(start, Q_BLOCK, s)[None], score, -jnp.inf)
        _, idx = lax.top_k(score, n_sel)
        kg = take(k, idx)
        vg = take(v, idx)
        logits = jnp.einsum('bhqd,bhqnd->bhqn', qb, kg).astype(jnp.float32) * scale
        valid = idx <= q_pos[None, :, None]
        p = jax.nn.softmax(jnp.where(valid[:, None], logits, -jnp.inf), axis=-1)
        return jnp.einsum('bhqn,bhqnd->bhqd', p.astype(vg.dtype), vg)

    o = _sweep_query_blocks(block, (q, iq, iw))
    return _merge_heads(o) @ w_out


def _diff_mixer(h, rope_diff, layer_idx, w_in, q_g, k_g, lq1, lk1, lq2, lk2, subln_g, w_out):
    b, s, _ = h.shape
    w = DIFF_HEADS * 2 * DIFF_DIM
    q, k, v = jnp.split(h @ w_in, [w, 2 * w], axis=-1)
    cos, sin = rope_diff
    q = _apply_rope(_rms_norm(_split_heads(q, 2 * DIFF_HEADS), q_g), cos, sin)
    k = _apply_rope(_rms_norm(_split_heads(k, 2 * DIFF_HEADS), k_g), cos, sin)
    v = _split_heads(v, DIFF_HEADS)
    lam_init = 0.8 - 0.6 * math.exp(-0.3 * layer_idx)
    f32 = jnp.float32
    lam = (jnp.exp(jnp.sum(lq1.astype(f32) * lk1.astype(f32)))
           - jnp.exp(jnp.sum(lq2.astype(f32) * lk2.astype(f32))) + lam_init)
    scale = DIFF_DIM ** -0.5

    def block(start, qb):
        logits = jnp.einsum('bhqd,bhkd->bhqk', qb, k).astype(f32) * scale
        logits = jnp.where(_causal_mask(start, Q_BLOCK, s), logits, -jnp.inf)
        p = jax.nn.softmax(logits, axis=-1).reshape(b, DIFF_HEADS, 2, Q_BLOCK, s)
        a = p[:, :, 0] - lam * p[:, :, 1]
        return jnp.einsum('bhqk,bhkd->bhqd', a.astype(v.dtype), v)

    o = _sweep_query_blocks(block, (q,))
    o = _rms_norm(o, subln_g) * (1.0 - lam_init)
    return _merge_heads(o) @ w_out


def _fox_mixer(h, w_in, b_f, q_g, k_g, w_out):
    b, s, _ = h.shape
    hd = N_HEADS * HEAD_DIM
    q, k, v, f, g = jnp.split(h @ w_in, [hd, 2 * hd, 3 * hd, 3 * hd + N_HEADS], axis=-1)
    q = _rms_norm(_split_heads(q, N_HEADS), q_g)
    k = _rms_norm(_split_heads(k, N_HEADS), k_g)
    v = _split_heads(v, N_HEADS)
    log_f = jax.nn.log_sigmoid(f.astype(jnp.float32) + b_f.astype(jnp.float32))
    cum = lax.cumsum(log_f, axis=1).transpose(0, 2, 1)
    scale = HEAD_DIM ** -0.5

    def block(start, qb, cq):
        logits = (jnp.einsum('bhqd,bhkd->bhqk', qb, k).astype(jnp.float32) * scale
                  + cq[..., None] - cum[:, :, None, :])
        logits = jnp.where(_causal_mask(start, Q_BLOCK, s), logits, -jnp.inf)
        p = jax.nn.softmax(logits, axis=-1)
        return jnp.einsum('bhqk,bhkd->bhqd', p.astype(v.dtype), v)

    o = _sweep_query_blocks(block, (q, cum))
    o = _merge_heads(o) * jax.nn.sigmoid(g)
    return o @ w_out


def _swiglu(h, w_gate_up, w_down):
    gate, up = jnp.split(h @ w_gate_up, 2, axis=-1)
    return (jax.nn.silu(gate) * up) @ w_down


def setup_inputs(seed: int = 0) -> dict:
    key = jax.random.key(seed)
    ks = iter(jax.random.split(key, 48))

    def normal(shape, scale):
        return jax.random.normal(next(ks), shape, jnp.float32) * scale

    def gain(shape):
        return 1.0 + normal(shape, 0.02)

    n_a, n_b, n_c, n_d = [len(range(m, DEPTH, N_MIXERS)) for m in range(N_MIXERS)]
    d = D_MODEL
    hd = N_HEADS * HEAD_DIM
    x = normal((BATCH, SEQ, d), 1.0)
    c = normal((BATCH, d), 1.0)
    positions = (jax.random.randint(next(ks), (BATCH, 1), 0, POS_OFFSET_MAX, dtype=jnp.int32)
                 + jnp.arange(SEQ, dtype=jnp.int32)[None, :])
    mla_in = MLA_Q_LORA + MLA_KV_LORA + MLA_ROPE
    dsa_in = 3 * hd + IDX_HEADS * IDX_DIM + IDX_DIM + IDX_HEADS
    diff_w = DIFF_HEADS * 2 * DIFF_DIM
    fox_in = 3 * hd + N_HEADS + hd
    return {
        'x': x,
        'c': c,
        'positions': positions,
        'ln_mix_g': gain((DEPTH, d)),
        'ln_ffn_g': gain((DEPTH, d)),
        'ada_w': normal((DEPTH, d, 6 * d), 0.5 * d ** -0.5),
        'ada_b': normal((DEPTH, 6 * d), 0.02),
        'ffn_w_gate_up': normal((DEPTH, d, 2 * FFN_HIDDEN), d ** -0.5),
        'ffn_w_down': normal((DEPTH, FFN_HIDDEN, d), FFN_HIDDEN ** -0.5),
        'mla_w_in': normal((n_a, d, mla_in), d ** -0.5),
        'mla_q_a_g': gain((n_a, MLA_Q_LORA)),
        'mla_kv_a_g': gain((n_a, MLA_KV_LORA)),
        'mla_w_q_b': normal((n_a, MLA_Q_LORA, N_HEADS * (MLA_ROPE + MLA_NOPE)), MLA_Q_LORA ** -0.5),
        'mla_w_kv_b': normal((n_a, MLA_KV_LORA, N_HEADS * (MLA_NOPE + MLA_V)), MLA_KV_LORA ** -0.5),
        'mla_q_g': gain((n_a, MLA_ROPE + MLA_NOPE)),
        'mla_k_g': gain((n_a, MLA_ROPE + MLA_NOPE)),
        'mla_w_out': normal((n_a, N_HEADS * MLA_V, d), (N_HEADS * MLA_V) ** -0.5),
        'dsa_w_in': normal((n_b, d, dsa_in), d ** -0.5),
        'dsa_q_g': gain((n_b, HEAD_DIM)),
        'dsa_k_g': gain((n_b, HEAD_DIM)),
        'dsa_idx_k_g': gain((n_b, IDX_DIM)),
        'dsa_w_out': normal((n_b, hd, d), hd ** -0.5),
        'diff_w_in': normal((n_c, d, 3 * diff_w), d ** -0.5),
        'diff_q_g': gain((n_c, DIFF_DIM)),
        'diff_k_g': gain((n_c, DIFF_DIM)),
        'diff_lambda_q1': normal((n_c, DIFF_DIM), 0.1),
        'diff_lambda_k1': normal((n_c, DIFF_DIM), 0.1),
        'diff_lambda_q2': normal((n_c, DIFF_DIM), 0.1),
        'diff_lambda_k2': normal((n_c, DIFF_DIM), 0.1),
        'diff_subln_g': gain((n_c, 2 * DIFF_DIM)),
        'diff_w_out': normal((n_c, diff_w, d), diff_w ** -0.5),
        'fox_w_in': normal((n_d, d, fox_in), d ** -0.5),
        'fox_b_f': jax.random.uniform(next(ks), (n_d, N_HEADS), jnp.float32, 1.0, 6.0),
        'fox_q_g': gain((n_d, HEAD_DIM)),
        'fox_k_g': gain((n_d, HEAD_DIM)),
        'fox_w_out': normal((n_d, hd, d), hd ** -0.5),
    }


def reference(x, c, positions, ln_mix_g, ln_ffn_g, ada_w, ada_b, ffn_w_gate_up, ffn_w_down,
              mla_w_in, mla_q_a_g, mla_kv_a_g, mla_w_q_b, mla_w_kv_b, mla_q_g, mla_k_g, mla_w_out,
              dsa_w_in, dsa_q_g, dsa_k_g, dsa_idx_k_g, dsa_w_out,
              diff_w_in, diff_q_g, diff_k_g, diff_lambda_q1, diff_lambda_k1, diff_lambda_q2,
              diff_lambda_k2, diff_subln_g, diff_w_out,
              fox_w_in, fox_b_f, fox_q_g, fox_k_g, fox_w_out):
    rope_head = _rope_cos_sin(positions, HEAD_DIM // ROPE_FRACTION)
    rope_idx = _rope_cos_sin(positions, IDX_DIM // ROPE_FRACTION)
    rope_diff = _rope_cos_sin(positions, DIFF_DIM // ROPE_FRACTION)
    rope_mla = _rope_cos_sin(positions, MLA_ROPE)
    cond = jax.nn.silu(c)
    for i in range(DEPTH):
        mod = (cond @ ada_w[i] + ada_b[i])[:, None, :]
        sh1, sc1, g1, sh2, sc2, g2 = jnp.split(mod, 6, axis=-1)
        h = _rms_norm(x, ln_mix_g[i]) * (1.0 + sc1) + sh1
        kind, j = i % N_MIXERS, i // N_MIXERS
        if kind == 0:
            y = _mla_mixer(h, rope_mla, mla_w_in[j], mla_q_a_g[j], mla_kv_a_g[j], mla_w_q_b[j],
                           mla_w_kv_b[j], mla_q_g[j], mla_k_g[j], mla_w_out[j])
        elif kind == 1:
            y = _dsa_mixer(h, rope_head, rope_idx, dsa_w_in[j], dsa_q_g[j], dsa_k_g[j],
                           dsa_idx_k_g[j], dsa_w_out[j])
        elif kind == 2:
            y = _diff_mixer(h, rope_diff, i, diff_w_in[j], diff_q_g[j], diff_k_g[j],
                            diff_lambda_q1[j], diff_lambda_k1[j], diff_lambda_q2[j],
                            diff_lambda_k2[j], diff_subln_g[j], diff_w_out[j])
        else:
            y = _fox_mixer(h, fox_w_in[j], fox_b_f[j], fox_q_g[j], fox_k_g[j], fox_w_out[j])
        x = x + g1 * y
        h = _rms_norm(x, ln_ffn_g[i]) * (1.0 + sc2) + sh2
        x = x + g2 * _swiglu(h, ffn_w_gate_up[i], ffn_w_down[i])
    return x
```

```cpp
#include <hip/hip_runtime.h>
#include <cstdio>
#include <cstdint>

#ifndef REP_MASK
#define REP_MASK 0
#endif
#define LAS __attribute__((address_space(3)))
typedef unsigned short bf16;
typedef short bf16x8 __attribute__((ext_vector_type(8)));
typedef float f32x4 __attribute__((ext_vector_type(4)));
typedef float f32x2 __attribute__((ext_vector_type(2)));
typedef float f32x16 __attribute__((ext_vector_type(16)));
typedef unsigned u32x4 __attribute__((ext_vector_type(4)));
typedef unsigned u32x2 __attribute__((ext_vector_type(2)));
typedef unsigned long long u64;

constexpr int S = 8192, D = 2048, NH = 16, FF = 5632, NMOD = 6 * D;
constexpr float EPS = 1e-6f;
constexpr int N_MLA_IN = 1280, N_DSA_IN = 7424, N_DIFF_IN = 6144, N_FOX_IN = 8448;
enum { I_X = 0, I_C, I_POS, I_LN_MIX, I_LN_FFN, I_ADA_W, I_ADA_B, I_FFN_GU, I_FFN_DN,
       I_MLA_IN, I_MLA_QAG, I_MLA_KVAG, I_MLA_QB, I_MLA_KVB, I_MLA_QG, I_MLA_KG, I_MLA_OUT,
       I_DSA_IN, I_DSA_QG, I_DSA_KG, I_DSA_IKG, I_DSA_OUT,
       I_DIFF_IN, I_DIFF_QG, I_DIFF_KG, I_DIFF_LQ1, I_DIFF_LK1, I_DIFF_LQ2, I_DIFF_LK2, I_DIFF_SUBG, I_DIFF_OUT,
       I_FOX_IN, I_FOX_BF, I_FOX_QG, I_FOX_KG, I_FOX_OUT, N_IN };

constexpr size_t MiB = 1u << 20;
constexpr size_t WS_CTL = 0;
constexpr size_t WS_MODP = 1 * MiB;
constexpr size_t WS_MOD = 3 * MiB;
constexpr size_t WS_ROPE64 = 4 * MiB;
constexpr size_t WS_ROPE32 = 6 * MiB;
constexpr size_t WS_ROPE16 = 7 * MiB;
constexpr size_t WS_IW = 8 * MiB;
constexpr size_t WS_LOGF = 9 * MiB;
constexpr size_t WS_CUM = 10 * MiB;
constexpr size_t WS_W_MLA_IN = 16 * MiB;
constexpr size_t WS_W_MLA_QB = 21 * MiB;
constexpr size_t WS_W_MLA_KVB = 24 * MiB;
constexpr size_t WS_W_DSA_IN = 28 * MiB;
constexpr size_t WS_W_DIFF_IN = 57 * MiB;
constexpr size_t WS_W_FOX_IN = 81 * MiB;
constexpr size_t WS_W_OUT = 114 * MiB;
constexpr size_t WS_W_GU = 146 * MiB;
constexpr size_t WS_W_DN = 322 * MiB;
constexpr size_t WS_XB = 410 * MiB;
constexpr size_t WS_P = 442 * MiB;
constexpr size_t WS_PM = 574 * MiB;
constexpr size_t WS_CN = 594 * MiB;
constexpr size_t WS_Q = 610 * MiB;
constexpr size_t WS_K = 658 * MiB;
constexpr size_t WS_O = 706 * MiB;
constexpr size_t WS_HID = 738 * MiB;
constexpr size_t WS_MASK = 826 * MiB;
constexpr size_t WS_SIDX = 834 * MiB;
constexpr size_t WS_O1 = 1090 * MiB;
constexpr size_t WS_STAT = 11 * MiB;
constexpr size_t WS_GG = 12 * MiB;
constexpr size_t WS_BIAS = 13 * MiB;
constexpr size_t WS_BIASP = 1154 * MiB;
constexpr size_t WS_XL = 1170 * MiB;
constexpr size_t WS_END = 1202 * MiB;
constexpr size_t CTL_ZERO_BYTES = 1 * MiB;
constexpr int CW_BAR = 4096;

constexpr int LDS_BYTES = 147456;
constexpr int MISC_OFF = LDS_BYTES - 128;

__device__ __forceinline__ unsigned f2bf(float f) { unsigned u = __builtin_bit_cast(unsigned, f); return (u + 0x7fffu + ((u >> 16) & 1u)) >> 16; }
__device__ __forceinline__ unsigned pk2(float lo, float hi) { return f2bf(lo) | (f2bf(hi) << 16); }
__device__ __forceinline__ float bf2f(unsigned b) { return __builtin_bit_cast(float, b << 16); }
__device__ __forceinline__ float wave_sum(float v) {
#pragma unroll
    for (int o = 32; o >= 1; o >>= 1) v += __shfl_xor(v, o);
    return v;
}
__device__ __forceinline__ float wave_max(float v) {
#pragma unroll
    for (int o = 32; o >= 1; o >>= 1) v = fmaxf(v, __shfl_xor(v, o));
    return v;
}

#define XB_TMO      128
#define XB_XCNT(j)  (256  + 64 * (j))
#define XB_XSUB(j)  (1280 + 64 * (j))
#define XB_XGEN(j)  (2304 + 64 * (j))
#define XB_TOP      3328
#define XB_TOPGEN   3392
#define XCD_BAR_WORDS 3456
#define XB_SPIN_CAP (1u << 22)
__device__ __forceinline__ unsigned xb_ld(unsigned* p)              { return __hip_atomic_load(p, __ATOMIC_RELAXED, __HIP_MEMORY_SCOPE_AGENT); }
__device__ __forceinline__ unsigned xb_add(unsigned* p, unsigned v) { return __hip_atomic_fetch_add(p, v, __ATOMIC_RELAXED, __HIP_MEMORY_SCOPE_AGENT); }
__device__ __forceinline__ unsigned xb_xcc_id() { return (unsigned)__builtin_amdgcn_s_getreg((3 << 11) | 20) & 0xFu; }
#define XB_SPIN(cond, bar) do { unsigned _sp = 0; while (cond) { __builtin_amdgcn_s_sleep(1); \
    if ((++_sp & 255u) == 0u) { if (xb_ld(&(bar)[XB_TMO])) break; if (_sp > XB_SPIN_CAP) { atomicAdd(&(bar)[XB_TMO], 1u); break; } } } } while (0)
__device__ __forceinline__ int tid_of(int wave) { int l; asm volatile("v_mbcnt_lo_u32_b32 %0, -1, 0\n\tv_mbcnt_hi_u32_b32 %0, -1, %0" : "=v"(l)); return wave * 64 + l; }
struct XcdBarrier { unsigned* bar; unsigned x; volatile LAS unsigned* st; int wave; };
__device__ __forceinline__ XcdBarrier xcd_barrier_post(unsigned* bar, volatile LAS unsigned* st, int wave) {
    XcdBarrier b; b.bar = bar; b.x = xb_xcc_id(); b.st = st; b.wave = wave;
    if (tid_of(wave) == 0) (void)xb_add(&bar[XB_XCNT(b.x)], 1u);
    return b;
}
__device__ __forceinline__ void xcd_barrier_complete(unsigned* bar, unsigned x, unsigned& nloc, unsigned& nx) {
    const unsigned G = gridDim.x * gridDim.y * gridDim.z;
    unsigned sum, cnt, mine, sp = 0u;
    for (;;) {
        sum = 0u; cnt = 0u; mine = 0u;
#pragma unroll
        for (unsigned j = 0; j < 16; ++j) { const unsigned c = xb_ld(&bar[XB_XCNT(j)]); sum += c; cnt += (c > 0u) ? 1u : 0u; mine = (j == x) ? c : mine; }
        if (sum == G) break;
        __builtin_amdgcn_s_sleep(1);
        if ((++sp & 255u) == 0u) { if (xb_ld(&bar[XB_TMO])) break; if (sp > XB_SPIN_CAP) { atomicAdd(&bar[XB_TMO], 1u); break; } }
    }
    nloc = mine > 0u ? mine : 1u; nx = cnt > 0u ? cnt : 1u;
}
__device__ __forceinline__ void xcd_barrier(const XcdBarrier& b) {
    asm volatile("s_waitcnt vmcnt(0)" ::: "memory");
    __syncthreads();
    if (tid_of(b.wave) == 0) {
        unsigned* bar = b.bar;
        __builtin_amdgcn_s_waitcnt(0);
        unsigned nloc = b.st[0], nx = b.st[1];
        if (nloc == 0u) { xcd_barrier_complete(bar, b.x, nloc, nx); b.st[0] = nloc; b.st[1] = nx; }
        const unsigned old = xb_add(&bar[XB_XSUB(b.x)], 1u);
        const unsigned gen = old / nloc;
        if (old + 1u == (gen + 1u) * nloc) {
            __builtin_amdgcn_fence(__ATOMIC_RELEASE, "agent");
            asm volatile("s_waitcnt vmcnt(0)" ::: "memory");
            const unsigned og = xb_add(&bar[XB_TOP], 1u);
            const unsigned tg = og / nx;
            if (og + 1u == (tg + 1u) * nx) xb_add(&bar[XB_TOPGEN], 1u);
            else XB_SPIN(xb_ld(&bar[XB_TOPGEN]) == tg, bar);
            __builtin_amdgcn_fence(__ATOMIC_ACQUIRE, "agent");
            xb_add(&bar[XB_XGEN(b.x)], 1u);
            asm volatile("s_waitcnt vmcnt(0)" ::: "memory");
        } else {
            XB_SPIN(xb_ld(&bar[XB_XGEN(b.x)]) == gen, bar);
            __builtin_amdgcn_fence(__ATOMIC_ACQUIRE, "agent");
            asm volatile("s_waitcnt vmcnt(0)" ::: "memory");
        }
    }
    __syncthreads();
}

struct Args { const void* in[N_IN]; float* out; unsigned char* ws; int ph_lo, ph_hi; };

struct Ctx { LAS unsigned char* lds; int tid, lane, wave, gw, ngw, G, blk; };
#define GAS __attribute__((address_space(1)))
__device__ __forceinline__ unsigned char* launder_ptr(unsigned char* p) { GAS unsigned char* g = (GAS unsigned char*)p; asm volatile("" : "+s"(g)); return (unsigned char*)g; }
__device__ __forceinline__ void fresh(Ctx& c) { int l; asm volatile("v_mbcnt_lo_u32_b32 %0, -1, 0\n\tv_mbcnt_hi_u32_b32 %0, -1, %0" : "=v"(l)); c.lane = l; c.tid = c.wave * 64 + l; }


constexpr int BO_MLA = 0, BO_DSA = BO_MLA + N_MLA_IN, BO_DIFF = BO_DSA + N_DSA_IN, BO_FOX = BO_DIFF + N_DIFF_IN, BO_GU = BO_FOX + N_FOX_IN, NBIAS = BO_GU + 4 * 2 * FF;
static_assert(NBIAS == 68352, "bias columns");

__device__ __forceinline__ int srccol(int kind, int n, int nsrc) {
    if (kind == 0) return n < nsrc ? n : -1;
    if (kind == 1) { const int t = n >> 8, w = n & 255; return w < 128 ? t * 128 + w : FF + t * 128 + (w - 128); }
    if (n < 6144) return n; if (n < 8192) return n + 16; if (n < 8208) return 6144 + (n - 8192); return -1;
}
__device__ __forceinline__ void transpose_item(const float* W, int K, int nsrc, bf16* WT, int kind, int k0, int n0, const float* gg, const float* sh, float* biasp, int lane) {
    const int n4 = lane & 7, kb = lane >> 3, n = n0 + 4 * n4, col = srccol(kind, n, nsrc);
    f32x4 v[8];
    const float* src = W + (size_t)(k0 + 8 * kb) * nsrc + (col >= 0 ? col : 0);
#pragma unroll
    for (int i = 0; i < 8; ++i) v[i] = __builtin_nontemporal_load((const f32x4*)(src + (size_t)i * nsrc));
    const float msk = col >= 0 ? 1.f : 0.f;
    float sc[8];
#pragma unroll
    for (int i = 0; i < 8; ++i) sc[i] = msk;
    if (gg) { const f32x4 g0 = *(const f32x4*)(gg + k0 + 8 * kb), g1 = *(const f32x4*)(gg + k0 + 8 * kb + 4), s0 = *(const f32x4*)(sh + k0 + 8 * kb), s1 = *(const f32x4*)(sh + k0 + 8 * kb + 4);
        float b[4];
#pragma unroll
        for (int j = 0; j < 4; ++j) { b[j] = (s0[0] * v[0][j] + s0[1] * v[1][j] + s0[2] * v[2][j] + s0[3] * v[3][j] + s1[0] * v[4][j] + s1[1] * v[5][j] + s1[2] * v[6][j] + s1[3] * v[7][j]) * msk;
            b[j] += __shfl_xor(b[j], 8); b[j] += __shfl_xor(b[j], 16); b[j] += __shfl_xor(b[j], 32); }
        if (kb == 0) *(f32x4*)(biasp + n) = (f32x4){b[0], b[1], b[2], b[3]};
#pragma unroll
        for (int i = 0; i < 4; ++i) { sc[i] *= g0[i]; sc[4 + i] *= g1[i]; } }
    bf16* dst = WT + (size_t)n * K + k0 + 8 * kb;
#pragma unroll
    for (int j = 0; j < 4; ++j) { u32x4 o; o.x = pk2(v[0][j] * sc[0], v[1][j] * sc[1]); o.y = pk2(v[2][j] * sc[2], v[3][j] * sc[3]); o.z = pk2(v[4][j] * sc[4], v[5][j] * sc[5]); o.w = pk2(v[6][j] * sc[6], v[7][j] * sc[7]);
        *(u32x4*)(dst + (size_t)j * K) = o; }
}
struct WDesc { int in_idx; int layer; int K, nsrc, npad, kind; size_t dst; int norm  , bo; };
__device__ __forceinline__ WDesc wdesc(int m) {
    switch (m) {
    case 0: return {I_MLA_IN, 0, D, 1088, N_MLA_IN, 0, WS_W_MLA_IN, 0, BO_MLA};
    case 1: return {I_MLA_QB, 0, 512, 3072, 3072, 0, WS_W_MLA_QB, -1, 0};
    case 2: return {I_MLA_KVB, 0, 512, 4096, 4096, 0, WS_W_MLA_KVB, -1, 0};
    case 3: return {I_MLA_OUT, 0, D, D, D, 0, WS_W_OUT + 0 * 8 * MiB, -1, 0};
    case 4: return {I_DSA_IN, 0, D, 7248, N_DSA_IN, 0, WS_W_DSA_IN, 1, BO_DSA};
    case 5: return {I_DSA_OUT, 0, D, D, D, 0, WS_W_OUT + 1 * 8 * MiB, -1, 0};
    case 6: return {I_DIFF_IN, 0, D, 6144, N_DIFF_IN, 0, WS_W_DIFF_IN, 2, BO_DIFF};
    case 7: return {I_DIFF_OUT, 0, D, D, D, 0, WS_W_OUT + 2 * 8 * MiB, -1, 0};
    case 8: return {I_FOX_IN, 0, D, 8208, N_FOX_IN, 2, WS_W_FOX_IN, 3, BO_FOX};
    case 9: return {I_FOX_OUT, 0, D, D, D, 0, WS_W_OUT + 3 * 8 * MiB, -1, 0};
    case 10: case 11: case 12: case 13: return {I_FFN_GU, m - 10, D, 2 * FF, 2 * FF, 1, WS_W_GU + (size_t)(m - 10) * 44 * MiB, 4 + (m - 10), BO_GU + (m - 10) * 2 * FF};
    default: return {I_FFN_DN, m - 14, FF, D, D, 0, WS_W_DN + (size_t)(m - 14) * 22 * MiB, -1, 0};
    }
}
__device__ __forceinline__ void ph_phase0(const Args& a, const Ctx& c) {
    LAS float* cond = (LAS float*)c.lds;
    const float* cin = (const float*)a.in[I_C];
    for (int i = c.tid; i < D; i += 512) { const float v = cin[i]; cond[i] = v / (1.f + __expf(-v)); }
    __syncthreads();
    {
        const float* W = (const float*)a.in[I_ADA_W]; float* modp = (float*)(a.ws + WS_MODP);
        for (int task = c.gw; task < 4 * 48 * 8; task += c.ngw) {
            const int ks = task & 7, cg = (task >> 3) % 48, l = task / (8 * 48);
            const float* wp = W + ((size_t)l * D + ks * 256) * NMOD + cg * 256 + c.lane * 4;
            f32x4 acc = {0.f, 0.f, 0.f, 0.f};
#pragma unroll 8
            for (int k = 0; k < 256; ++k) { const f32x4 w = __builtin_nontemporal_load((const f32x4*)(wp + (size_t)k * NMOD)); acc += w * cond[ks * 256 + k]; }
            *(f32x4*)(modp + ((size_t)(ks * 4 + l)) * NMOD + cg * 256 + c.lane * 4) = acc;
        }
    }
    {
        const int* pos = (const int*)a.in[I_POS];
        f32x2* r64 = (f32x2*)(a.ws + WS_ROPE64); f32x2* r32 = (f32x2*)(a.ws + WS_ROPE32); f32x2* r16 = (f32x2*)(a.ws + WS_ROPE16);
        const int gt = c.blk * 512 + c.tid, ngt = c.G * 512;
        for (int i = gt; i < S * 56; i += ngt) {
            const int t = i / 56, j = i % 56; int rot, fi; f32x2* dst;
            if (j < 32) { rot = 64; fi = j; dst = r64 + t * 32 + fi; } else if (j < 48) { rot = 32; fi = j - 32; dst = r32 + t * 16 + fi; } else { rot = 16; fi = j - 48; dst = r16 + t * 8 + fi; }
            const float invf = (float)exp2(-(double)(2 * fi) / (double)rot * 18.931568569324174);
            const float ang = (float)pos[t] * invf;
            double rev = (double)ang * 0.15915494309189535; rev -= rint(rev);
            const float rv = (float)rev;
            *dst = (f32x2){__builtin_amdgcn_cosf(rv), __builtin_amdgcn_sinf(rv)};
        }
    }
    {
        const float* x = (const float*)a.in[I_X]; bf16* xb = (bf16*)(a.ws + WS_XB); bf16* xl = (bf16*)(a.ws + WS_XL); float* stat = (float*)(a.ws + WS_STAT);
        f32x4 nx[8];
        { const f32x4* xr = (const f32x4*)(x + (size_t)(c.gw < S ? c.gw : 0) * D) + c.lane;
#pragma unroll
          for (int j = 0; j < 8; ++j) nx[j] = xr[64 * j]; }
        for (int r = c.gw; r < S; r += c.ngw) {
            u32x2* o = (u32x2*)(xb + (size_t)r * D) + c.lane; u32x2* ol = (u32x2*)(xl + (size_t)r * D) + c.lane; float ss = 0.f;
            f32x4 cx[8];
#pragma unroll
            for (int j = 0; j < 8; ++j) cx[j] = nx[j];
            { const int rn = r + c.ngw < S ? r + c.ngw : r; const f32x4* xr = (const f32x4*)(x + (size_t)rn * D) + c.lane;
#pragma unroll
              for (int j = 0; j < 8; ++j) nx[j] = xr[64 * j]; }
#pragma unroll
            for (int j = 0; j < 8; ++j) { const f32x4 v = cx[j]; ss += v.x * v.x + v.y * v.y + v.z * v.z + v.w * v.w; const unsigned h0 = pk2(v.x, v.y), h1 = pk2(v.z, v.w);
                o[64 * j] = (u32x2){h0, h1}; ol[64 * j] = (u32x2){pk2(v.x - bf2f(h0 & 0xffffu), v.y - bf2f(h0 >> 16)), pk2(v.z - bf2f(h1 & 0xffffu), v.w - bf2f(h1 >> 16))}; }
            ss = wave_sum(ss);
            if (c.lane < 8) stat[r * 8 + c.lane] = c.lane == 0 ? ss : 0.f;
        }
    }
}
__device__ __forceinline__ void ph_modfinal(const Args& a, const Ctx& c) {
    const float* modp = (const float*)(a.ws + WS_MODP); const float* b = (const float*)a.in[I_ADA_B]; float* mod = (float*)(a.ws + WS_MOD); float* gg = (float*)(a.ws + WS_GG);
    for (int i = c.blk * 512 + c.tid; i < 4 * NMOD; i += c.G * 512) {
        const int l = i / NMOD, col = i % NMOD; float s = b[i];
#pragma unroll
        for (int ks = 0; ks < 8; ++ks) s += modp[(size_t)(ks * 4 + l) * NMOD + col];
        mod[i] = s;
        const int seg = col / D, k = col % D;
        if (seg == 1) gg[l * D + k] = ((const float*)a.in[I_LN_MIX])[l * D + k] * (1.f + s);
        if (seg == 4) gg[(4 + l) * D + k] = ((const float*)a.in[I_LN_FFN])[l * D + k] * (1.f + s);
    }
}
__device__ __forceinline__ void ph_weights(const Args& a, const Ctx& c) {
    const float* mod = (const float*)(a.ws + WS_MOD); const float* gga = (const float*)(a.ws + WS_GG); float* biasp = (float*)(a.ws + WS_BIASP);
    for (int m = 0; m < 18; ++m) {
        const WDesc d = wdesc(m);
        const float* W = (const float*)a.in[d.in_idx] + (size_t)d.layer * d.K * d.nsrc;
        bf16* WT = (bf16*)(a.ws + d.dst);
        const float* gg = d.norm >= 0 ? gga + d.norm * D : nullptr;
        const float* sh = d.norm >= 0 ? mod + (d.norm & 3) * NMOD + (d.norm >= 4 ? 3 * D : 0) : nullptr;
        const int nblk = d.npad / 32, nitems = (d.K / 64) * nblk;
        for (int it = c.gw; it < nitems; it += c.ngw) { const int kt = it / nblk, n0 = 32 * (it % nblk);
            transpose_item(W, d.K, d.nsrc, WT, d.kind, 64 * kt, n0, gg, sh, biasp + (size_t)kt * NBIAS + d.bo, c.lane); }
    }
}
namespace pg8 {
constexpr int BM = 256, BK = 64, HALF = 128, HTB = HALF * BK * 2, STAGE_BYTES = 8 * HTB, NXCD = 8, WGM = 8;
__host__ __device__ __forceinline__ int lds_byte(int r, int c) { const int st = (r >> 4) * 2 + (c >> 5), rr = r & 15, cc = c & 31, ob = rr * 64 + cc * 2; return st * 1024 + (ob ^ (((ob >> 9) & 1) << 5)); }
__host__ __device__ __forceinline__ void stage_rc(int b, int& R, int& C) { const int st = b / 1024, sb = b % 1024, swz = sb ^ (((sb >> 9) & 1) << 5); R = (st >> 1) * 16 + swz / 64; C = (st & 1) * 32 + (swz % 64) / 2; }
__host__ __device__ __forceinline__ int perm32(int rho) { const int n = rho >> 4, i = rho & 15; return 8 * (i >> 2) + 4 * n + (i & 3); }
struct Unit { int pm, pn, hsel; };
struct Gemm { const bf16* A; int lda; const bf16* Bt; int ldb; int M, N, K; };
struct StaticOrder {
    int nM, nN, nwg, G, c, nhalf;
    __device__ void init(int M, int N, int G_, int c_, int nht = 0) { nM = M / BM; nN = N / BM - nht; nwg = nM * nN; G = G_; c = c_; nhalf = 2 * nM * nht; }
    __device__ bool next(int i, Unit& u) const {
        const long L = (long)i * G + c; if (L >= nwg + nhalf) return false;
        const bool isH = L >= nwg; const int h = (int)L - nwg;
        int wgid = isH ? 0 : (int)L; { const int q = nwg / NXCD, r = nwg % NXCD, xcd = wgid % NXCD, off = wgid / NXCD; wgid = (xcd < r ? xcd * (q + 1) : r * (q + 1) + (xcd - r) * q) + off; }
        const int nig = WGM * nN, gid = wgid / nig, fm = gid * WGM, gsz = (nM - fm) < WGM ? (nM - fm) : WGM;
        const int fpm = fm + ((wgid % nig) % gsz), fpn = (wgid % nig) / gsz;
        u.pm = isH ? (h >> 1) % nM : fpm; u.pn = isH ? nN + (h >> 1) / nM : fpn; u.hsel = isH ? (h & 1) : -1; return true;
    }
};
__device__ __forceinline__ unsigned cvt_pk_bf16(float lo, float hi) { unsigned r; asm volatile("v_cvt_pk_bf16_f32 %0, %1, %2" : "=v"(r) : "v"(lo), "v"(hi)); return r; }
__device__ __forceinline__ float row_rstd(const float* stat, int row) { const f32x4 a = *(const f32x4*)(stat + row * 8), b = *(const f32x4*)(stat + row * 8 + 4);
    return rsqrtf(((a.x + a.y) + (a.z + a.w) + (b.x + b.y) + (b.z + b.w)) * (1.f / D) + EPS); }
struct EpiStoreP { bf16* O; int ldc; const float* stat; const float* bias;
    __device__ __forceinline__ void operator()(const f32x4 (&acc)[2][2][4][2], const Unit& u, int wr, int wc, int fr, int fq, LAS unsigned char*) const {
        const int row0 = u.pm * BM + (u.hsel > 0 ? HALF : 0) + wr * 64 + fr, col0 = u.pn * BM + wc * 32 + 8 * fq; const int nai = u.hsel >= 0 ? 1 : 2;
        f32x4 bv[2][2];
#pragma unroll
        for (int bj = 0; bj < 2; ++bj)
#pragma unroll
            for (int n = 0; n < 2; ++n) bv[bj][n] = stat ? *(const f32x4*)(bias + col0 + bj * HALF + 4 * n) : (f32x4){0.f, 0.f, 0.f, 0.f};
        float rsv[2][4];
#pragma unroll
        for (int ai = 0; ai < 2; ++ai) if (ai < nai)
#pragma unroll
            for (int m = 0; m < 4; ++m) rsv[ai][m] = stat ? row_rstd(stat, row0 + ai * HALF + m * 16) : 1.f;
#pragma unroll
        for (int ai = 0; ai < 2; ++ai) if (ai < nai)
#pragma unroll
            for (int m = 0; m < 4; ++m) { const int row = row0 + ai * HALF + m * 16; bf16* rowp = O + (size_t)row * ldc + col0;
                const float rs = rsv[ai][m];
#pragma unroll
                for (int bj = 0; bj < 2; ++bj) { const f32x4 v0 = acc[ai][bj][m][0] * rs + bv[bj][0], v1 = acc[ai][bj][m][1] * rs + bv[bj][1];
                    u32x4 w; w.x = cvt_pk_bf16(v0[0], v0[1]); w.y = cvt_pk_bf16(v0[2], v0[3]); w.z = cvt_pk_bf16(v1[0], v1[1]); w.w = cvt_pk_bf16(v1[2], v1[3]);
                    *(u32x4*)(rowp + bj * HALF) = w; } }
    } };
template <bool LAST>
struct EpiResP { bf16* xb; bf16* xl; const float* g; float* stat; float* fout;
    __device__ __forceinline__ void operator()(const f32x4 (&acc)[2][2][4][2], const Unit& u, int wr, int wc, int fr, int fq, LAS unsigned char* lds) const {
        const int col0 = u.pn * BM + wc * 32 + 8 * fq;
        LAS float* part = (LAS float*)(lds + 132096);
        f32x4 gv[2][2];
#pragma unroll
        for (int bj = 0; bj < 2; ++bj)
#pragma unroll
            for (int n = 0; n < 2; ++n) gv[bj][n] = *(const f32x4*)(g + col0 + bj * HALF + 4 * n);
#pragma unroll
        for (int ai = 0; ai < 2; ++ai) {
            u32x4 hv[4][2], lv[4][2];
#pragma unroll
            for (int m = 0; m < 4; ++m) { const size_t o = (size_t)(u.pm * BM + wr * 64 + fr + ai * HALF + m * 16) * D + col0;
#pragma unroll
                for (int bj = 0; bj < 2; ++bj) { hv[m][bj] = *(const u32x4*)(xb + o + bj * HALF); lv[m][bj] = *(const u32x4*)(xl + o + bj * HALF); } }
#pragma unroll
            for (int m = 0; m < 4; ++m) { const int rl = wr * 64 + fr + ai * HALF + m * 16; const size_t o = (size_t)(u.pm * BM + rl) * D + col0; float ss = 0.f;
#pragma unroll
                for (int bj = 0; bj < 2; ++bj) { const size_t oo = o + bj * HALF; float xn[8];
#pragma unroll
                    for (int e = 0; e < 4; ++e) { const unsigned hw = hv[m][bj][e], lw = lv[m][bj][e];
                        xn[2 * e] = (bf2f(hw & 0xffffu) + bf2f(lw & 0xffffu)) + gv[bj][e >> 1][(2 * e) & 3] * acc[ai][bj][m][e >> 1][(2 * e) & 3];
                        xn[2 * e + 1] = (bf2f(hw >> 16) + bf2f(lw >> 16)) + gv[bj][e >> 1][(2 * e + 1) & 3] * acc[ai][bj][m][e >> 1][(2 * e + 1) & 3]; }
                    ss += (xn[0] * xn[0] + xn[1] * xn[1]) + (xn[2] * xn[2] + xn[3] * xn[3]) + (xn[4] * xn[4] + xn[5] * xn[5]) + (xn[6] * xn[6] + xn[7] * xn[7]);
                    if constexpr (LAST) { *(f32x4*)(fout + oo) = (f32x4){xn[0], xn[1], xn[2], xn[3]}; *(f32x4*)(fout + oo + 4) = (f32x4){xn[4], xn[5], xn[6], xn[7]}; }
                    else { u32x4 w, wl;
#pragma unroll
                        for (int e = 0; e < 4; ++e) { w[e] = cvt_pk_bf16(xn[2 * e], xn[2 * e + 1]); wl[e] = cvt_pk_bf16(xn[2 * e] - bf2f(w[e] & 0xffffu), xn[2 * e + 1] - bf2f(w[e] >> 16)); }
                        *(u32x4*)(xb + oo) = w; *(u32x4*)(xl + oo) = wl; } }
                ss += __shfl_xor(ss, 16); ss += __shfl_xor(ss, 32);
                if (fq == 0) part[rl * 4 + wc] = ss; } }
        asm volatile("s_waitcnt lgkmcnt(0)" ::: "memory"); __builtin_amdgcn_s_barrier();
        const int tid = (wr * 4 + wc) * 64 + fq * 16 + fr;
        if (tid < 256) { const f32x4 p = *(const LAS f32x4*)(part + tid * 4); stat[(size_t)(u.pm * BM + tid) * 8 + u.pn] = (p.x + p.y) + (p.z + p.w); }
    } };
struct EpiSwigluP { bf16* Hd; const float* stat; const float* bias;
    __device__ __forceinline__ void operator()(const f32x4 (&acc)[2][2][4][2], const Unit& u, int wr, int wc, int fr, int fq, LAS unsigned char*) const {
        const int row0 = u.pm * BM + (u.hsel > 0 ? HALF : 0) + wr * 64 + fr, hc0 = u.pn * HALF + wc * 32 + 8 * fq, col0 = u.pn * BM + wc * 32 + 8 * fq; const int nai = u.hsel >= 0 ? 1 : 2;
        f32x4 bv[2][2];
#pragma unroll
        for (int bj = 0; bj < 2; ++bj)
#pragma unroll
            for (int n = 0; n < 2; ++n) bv[bj][n] = *(const f32x4*)(bias + col0 + bj * HALF + 4 * n);
        float rsv[2][4];
#pragma unroll
        for (int ai = 0; ai < 2; ++ai) if (ai < nai)
#pragma unroll
            for (int m = 0; m < 4; ++m) rsv[ai][m] = row_rstd(stat, row0 + ai * HALF + m * 16);
#pragma unroll
        for (int ai = 0; ai < 2; ++ai) if (ai < nai)
#pragma unroll
            for (int m = 0; m < 4; ++m) { const int row = row0 + ai * HALF + m * 16; const float rs = rsv[ai][m]; float r[8];
#pragma unroll
                for (int n = 0; n < 2; ++n)
#pragma unroll
                    for (int i = 0; i < 4; ++i) { const float gt = acc[ai][0][m][n][i] * rs + bv[0][n][i], up = acc[ai][1][m][n][i] * rs + bv[1][n][i]; r[4 * n + i] = gt * __builtin_amdgcn_rcpf(1.f + __expf(-gt)) * up; }
                u32x4 w; w.x = cvt_pk_bf16(r[0], r[1]); w.y = cvt_pk_bf16(r[2], r[3]); w.z = cvt_pk_bf16(r[4], r[5]); w.w = cvt_pk_bf16(r[6], r[7]);
                *(u32x4*)(Hd + (size_t)row * FF + hc0) = w; }
    } };

template <class Epi>
__device__ __forceinline__ void gemm_phase(LAS unsigned char* lds, const Gemm g, const StaticOrder& S, const Epi& E, const int wave) {
    const int tid = tid_of(wave), wid = wave, lane = tid & 63, wr = wid >> 2, wc = wid & 3, fr = lane & 15, fq = lane >> 4;
    const int K = g.K, nt = K / BK;
    unsigned voffA[2], voffB[2];
#pragma unroll
    for (int i = 0; i < 2; ++i) { int R, C; stage_rc(tid * 16 + i * 8192, R, C); const int Rb = (R & ~31) + perm32(R & 31);
        voffA[i] = (unsigned)(R * g.lda + C) * 2u; voffB[i] = (unsigned)(Rb * g.ldb + C) * 2u; }
    const size_t kstep = (size_t)(BK * 2);
    const size_t hstepA = (size_t)HALF * g.lda * 2, hstepB = (size_t)HALF * g.ldb * 2;
    const size_t tstepA = 2 * hstepA, tstepB = 2 * hstepB;
    const unsigned ldsw = (unsigned)wid * 1024u;
    const int aoff = lds_byte(wr * 64 + fr, fq * 8), boff = lds_byte(wc * 32 + fr, fq * 8);
#define PG8_SA(b, h) (((b) * 2 + (h)) * HTB)
#define PG8_SB(b, h) ((4 + (b) * 2 + (h)) * HTB)
#define PG8_STAGE(bufoff, gbase, voff) do { _Pragma("unroll") for (int _i = 0; _i < 2; ++_i) \
        __builtin_amdgcn_global_load_lds((const unsigned*)((const char*)(gbase) + (voff)[_i]), (LAS unsigned*)(lds + (bufoff) + ldsw + _i * 8192), 16, 0, 0); } while (0)
#define PG8_LDA(dst, b, h) do { _Pragma("unroll") for (int m = 0; m < 4; ++m) _Pragma("unroll") for (int k = 0; k < 2; ++k) dst[m][k] = *(const LAS bf16x8*)(lds + PG8_SA(b, h) + aoff + m * 2048 + k * 1024); } while (0)
#define PG8_LDB(dst, b, h) do { _Pragma("unroll") for (int n = 0; n < 2; ++n) _Pragma("unroll") for (int k = 0; k < 2; ++k) dst[n][k] = *(const LAS bf16x8*)(lds + PG8_SB(b, h) + boff + n * 2048 + k * 1024); } while (0)
#define PG8_MMA(ai, bj, At, Bt) do { __builtin_amdgcn_s_setprio(1); _Pragma("unroll") for (int m = 0; m < 4; ++m) _Pragma("unroll") for (int n = 0; n < 2; ++n) _Pragma("unroll") for (int k = 0; k < 2; ++k) \
        acc[ai][bj][m][n] = __builtin_amdgcn_mfma_f32_16x16x32_bf16(Bt[n][k], At[m][k], acc[ai][bj][m][n], 0, 0, 0); __builtin_amdgcn_s_setprio(0); } while (0)
#define PG8_WAIT_V(n) asm volatile("s_waitcnt vmcnt(" #n ")" ::: "memory")
#define PG8_WAIT_L(n) asm volatile("s_waitcnt lgkmcnt(" #n ")" ::: "memory")
#define PG8_BAR __builtin_amdgcn_s_barrier()
#define PG8_SCHED __builtin_amdgcn_sched_barrier(0)
    Unit cur, nxt; int ui = 0;
    if (!S.next(0, cur)) return;
    f32x4 acc[2][2][4][2];
#pragma unroll
    for (int a = 0; a < 2; ++a)
#pragma unroll
        for (int b = 0; b < 2; ++b)
#pragma unroll
            for (int m = 0; m < 4; ++m)
#pragma unroll
                for (int n = 0; n < 2; ++n) acc[a][b][m][n] = (f32x4){0.f, 0.f, 0.f, 0.f};
    bf16x8 At[4][2], B0[2][2], B1[2][2];
    const char* cA = (const char*)g.A + (size_t)cur.pm * tstepA + (cur.hsel > 0 ? hstepA : 0); const char* cB = (const char*)g.Bt + (size_t)cur.pn * tstepB;
    PG8_STAGE(PG8_SB(0, 0), cB, voffB); PG8_STAGE(PG8_SB(0, 1), cB + hstepB, voffB); PG8_STAGE(PG8_SA(0, 0), cA, voffA); PG8_STAGE(PG8_SA(0, 1), cA + hstepA, voffA);
    if (wr == 1) PG8_BAR;
    PG8_WAIT_V(2); PG8_BAR;
    PG8_STAGE(PG8_SB(1, 0), cB + kstep, voffB); PG8_STAGE(PG8_SA(1, 0), cA + kstep, voffA); PG8_STAGE(PG8_SB(1, 1), cB + hstepB + kstep, voffB);
    PG8_WAIT_V(6); PG8_BAR;
    for (;;) {
        const bool has_next = S.next(ui + 1, nxt);
        const char* nA = has_next ? (const char*)g.A + (size_t)nxt.pm * tstepA + (nxt.hsel > 0 ? hstepA : 0) : cA; const char* nB = has_next ? (const char*)g.Bt + (size_t)nxt.pn * tstepB : cB;
        const bool full = cur.hsel < 0;
        for (int t = 0; t < nt; t += 2) {
            const bool last = (t == nt - 2);
            const char* a1 = cA + (size_t)(t + 1) * kstep;
            const char* a2 = last ? nA : cA + (size_t)(t + 2) * kstep; const char* b2 = last ? nB : cB + (size_t)(t + 2) * kstep;
            const char* a3 = a2 + kstep; const char* b3 = b2 + kstep;
            PG8_LDB(B0, 0, 0); PG8_LDB(B1, 0, 1); PG8_SCHED; PG8_LDA(At, 0, 0); PG8_STAGE(PG8_SA(1, 1), a1 + hstepA, voffA);
            PG8_WAIT_V(8); PG8_WAIT_L(0); PG8_BAR; PG8_MMA(0, 0, At, B0); PG8_MMA(0, 1, At, B1); PG8_BAR; PG8_SCHED;
            PG8_LDA(At, 0, 1); PG8_STAGE(PG8_SB(0, 0), b2, voffB); PG8_STAGE(PG8_SB(0, 1), b2 + hstepB, voffB); PG8_STAGE(PG8_SA(0, 0), a2, voffA);
            PG8_WAIT_V(8); PG8_WAIT_L(0); PG8_BAR; if (full) { PG8_MMA(1, 0, At, B0); PG8_MMA(1, 1, At, B1); } PG8_BAR; PG8_SCHED;
            PG8_LDB(B0, 1, 0); PG8_LDB(B1, 1, 1); PG8_SCHED; PG8_LDA(At, 1, 0); PG8_STAGE(PG8_SA(0, 1), a2 + hstepA, voffA);
            PG8_WAIT_V(8); PG8_WAIT_L(0); PG8_BAR; PG8_MMA(0, 0, At, B0); PG8_MMA(0, 1, At, B1); PG8_BAR; PG8_SCHED;
            PG8_LDA(At, 1, 1); PG8_STAGE(PG8_SB(1, 0), b3, voffB); PG8_STAGE(PG8_SB(1, 1), b3 + hstepB, voffB); PG8_STAGE(PG8_SA(1, 0), a3, voffA);
            PG8_WAIT_V(8); PG8_WAIT_L(0); PG8_BAR; if (full) { PG8_MMA(1, 0, At, B0); PG8_MMA(1, 1, At, B1); } PG8_BAR; PG8_SCHED;
        }
        if (wr == 0) PG8_BAR;
        E(acc, cur, wr, wc, fr, fq, lds);
        if (!has_next) break;
#pragma unroll
        for (int a = 0; a < 2; ++a)
#pragma unroll
            for (int b = 0; b < 2; ++b)
#pragma unroll
                for (int m = 0; m < 4; ++m)
#pragma unroll
                    for (int n = 0; n < 2; ++n) acc[a][b][m][n] = (f32x4){0.f, 0.f, 0.f, 0.f};
        cur = nxt; cA = nA; cB = nB; ++ui;
        if (wr == 1) PG8_BAR;
    }
    PG8_WAIT_V(0);
    PG8_BAR;
#undef PG8_SA
#undef PG8_SB
#undef PG8_STAGE
#undef PG8_LDA
#undef PG8_LDB
#undef PG8_MMA
#undef PG8_WAIT_V
#undef PG8_WAIT_L
#undef PG8_BAR
#undef PG8_SCHED
}
}
__device__ __forceinline__ void bias_reduce(const float* biasp, float* bias, int M, int N, int G, int blk, int wave, int nht) {
    pg8::StaticOrder S_; S_.init(M, N, G, blk, nht); pg8::Unit u;
    const int tid = tid_of(wave);
    for (int i = 0; S_.next(i, u); ++i) if (tid < 256) { const int col = u.pn * 256 + tid; float s = 0.f;
#pragma unroll 8
        for (int kt = 0; kt < 32; ++kt) s += biasp[(size_t)kt * NBIAS + col];
        bias[col] = s; }
    asm volatile("s_waitcnt vmcnt(0)" ::: "memory"); __syncthreads();
}
__device__ __forceinline__ void bias_all(const float* biasp, float* bias, int c0, const Ctx& c) {
    for (int col = c0 + c.blk * 512 + c.tid; col < NBIAS; col += c.G * 512) { float s = 0.f;
#pragma unroll
        for (int kt = 0; kt < 32; ++kt) s += biasp[(size_t)kt * NBIAS + col];
        bias[col] = s; }
}
#define GEMM_SITE(EPI_P, Aptr, LDA, Bptr, LDB, MM, NN, KK, NHT) do { pg8::Gemm g_{Aptr, LDA, Bptr, LDB, MM, NN, KK}; pg8::StaticOrder S_; S_.init(MM, NN, c.G, c.blk, NHT); pg8::gemm_phase(c.lds, g_, S_, EPI_P, c.wave); } while (0)

template <int HD, int ROT, bool NORM>
__device__ __forceinline__ void heads8_norm_rope(const bf16* src0, const bf16* srcn, bf16* dst, const float* gain, const f32x2* rope, int lane) {
    constexpr int V = HD / 64; const int part = lane & 7;
    float x[V][8];
    { const u32x4 r = *(const u32x4*)src0;
#pragma unroll
      for (int e = 0; e < 4; ++e) { x[0][2 * e] = bf2f(r[e] & 0xffffu); x[0][2 * e + 1] = bf2f(r[e] >> 16); } }
#pragma unroll
    for (int v = 1; v < V; ++v) { const u32x4 r = *(const u32x4*)(srcn + 64 * (v - 1));
#pragma unroll
        for (int e = 0; e < 4; ++e) { x[v][2 * e] = bf2f(r[e] & 0xffffu); x[v][2 * e + 1] = bf2f(r[e] >> 16); } }
    if (NORM) { float ss = 0.f;
#pragma unroll
        for (int v = 0; v < V; ++v)
#pragma unroll
            for (int e = 0; e < 8; ++e) ss += x[v][e] * x[v][e];
        ss += __shfl_xor(ss, 1); ss += __shfl_xor(ss, 2); ss += __shfl_xor(ss, 4);
        const float r = rsqrtf(ss * (1.f / HD) + EPS);
#pragma unroll
        for (int v = 0; v < V; ++v) { const f32x4 g0 = *(const f32x4*)(gain + (part + 8 * v) * 8), g1 = *(const f32x4*)(gain + (part + 8 * v) * 8 + 4);
#pragma unroll
            for (int e = 0; e < 4; ++e) { x[v][e] *= r * g0[e]; x[v][4 + e] *= r * g1[e]; } } }
    if (ROT > 0) { constexpr int HL = ROT / 16 > 0 ? ROT / 16 : 1;
        float p[8];
#pragma unroll
        for (int e = 0; e < 8; ++e) p[e] = __shfl_xor(x[0][e], HL);
        if (part < 2 * HL) { const f32x2* rp = rope + (part & (HL - 1)) * 8; const bool lo = part < HL;
#pragma unroll
            for (int e = 0; e < 8; ++e) { const f32x2 cs = rp[e]; x[0][e] = lo ? x[0][e] * cs.x - p[e] * cs.y : x[0][e] * cs.x + p[e] * cs.y; } } }
#pragma unroll
    for (int v = 0; v < V; ++v) { u32x4 w; w.x = pk2(x[v][0], x[v][1]); w.y = pk2(x[v][2], x[v][3]); w.z = pk2(x[v][4], x[v][5]); w.w = pk2(x[v][6], x[v][7]);
        *(u32x4*)(dst + 64 * v) = w; }
}

template <int HD> struct H8R { u32x4 r[HD / 64]; };
template <int HD> struct H8G { f32x4 g[HD / 64][2]; };
struct H8C { f32x2 cs[8]; };
template <int HD> __device__ __forceinline__ void h8_load(H8R<HD>& a, const bf16* src0, const bf16* srcn) {
    a.r[0] = *(const u32x4*)src0;
#pragma unroll
    for (int v = 1; v < HD / 64; ++v) a.r[v] = *(const u32x4*)(srcn + 64 * (v - 1));
}
template <int HD> __device__ __forceinline__ void h8_gain(H8G<HD>& g, const float* gain, int part) {
#pragma unroll
    for (int v = 0; v < HD / 64; ++v) { g.g[v][0] = *(const f32x4*)(gain + (part + 8 * v) * 8); g.g[v][1] = *(const f32x4*)(gain + (part + 8 * v) * 8 + 4); }
}
template <int ROT> __device__ __forceinline__ void h8_rope(H8C& c, const f32x2* rope, int part) {
    constexpr int HL = ROT / 16 > 0 ? ROT / 16 : 1; const f32x2* rp = rope + (part & (HL - 1)) * 8;
#pragma unroll
    for (int e = 0; e < 8; ++e) c.cs[e] = rp[e];
}
template <int HD, int ROT, bool NORM>
__device__ __forceinline__ void h8_finish(const H8R<HD>& a, bf16* dst, const H8G<HD>& G, const H8C& C, int lane) {
    constexpr int V = HD / 64; const int part = lane & 7;
    float x[V][8];
#pragma unroll
    for (int v = 0; v < V; ++v)
#pragma unroll
        for (int e = 0; e < 4; ++e) { x[v][2 * e] = bf2f(a.r[v][e] & 0xffffu); x[v][2 * e + 1] = bf2f(a.r[v][e] >> 16); }
    if (NORM) { float ss = 0.f;
#pragma unroll
        for (int v = 0; v < V; ++v)
#pragma unroll
            for (int e = 0; e < 8; ++e) ss += x[v][e] * x[v][e];
        ss += __shfl_xor(ss, 1); ss += __shfl_xor(ss, 2); ss += __shfl_xor(ss, 4);
        const float r = rsqrtf(ss * (1.f / HD) + EPS);
#pragma unroll
        for (int v = 0; v < V; ++v)
#pragma unroll
            for (int e = 0; e < 4; ++e) { x[v][e] *= r * G.g[v][0][e]; x[v][4 + e] *= r * G.g[v][1][e]; } }
    if (ROT > 0) { constexpr int HL = ROT / 16 > 0 ? ROT / 16 : 1;
        float p[8];
#pragma unroll
        for (int e = 0; e < 8; ++e) p[e] = __shfl_xor(x[0][e], HL);
        if (part < 2 * HL) { const bool lo = part < HL;
#pragma unroll
            for (int e = 0; e < 8; ++e) { const f32x2 cs = C.cs[e]; x[0][e] = lo ? x[0][e] * cs.x - p[e] * cs.y : x[0][e] * cs.x + p[e] * cs.y; } } }
#pragma unroll
    for (int v = 0; v < V; ++v) { u32x4 w; w.x = pk2(x[v][0], x[v][1]); w.y = pk2(x[v][2], x[v][3]); w.z = pk2(x[v][4], x[v][5]); w.w = pk2(x[v][6], x[v][7]);
        *(u32x4*)(dst + 64 * v) = w; }
}

namespace fa {
#define SBAR() __builtin_amdgcn_sched_barrier(0)
typedef short s16x4 __attribute__((ext_vector_type(4)));
constexpr float LOG2E = 1.4426950408889634f;
constexpr float THR2 = 11.5f;
__device__ __forceinline__ int crow(int r, int hi) { return (r & 3) + 8 * (r >> 2) + 4 * hi; }
__device__ __forceinline__ unsigned cvtpk(float lo, float hi) { unsigned r; asm volatile("v_cvt_pk_bf16_f32 %0, %1, %2" : "=v"(r) : "v"(lo), "v"(hi)); return r; }
template <int DQK> __device__ __forceinline__ int kswz(int row, int colB) { return row * (DQK * 2) + (colB ^ ((DQK == 128 ? (row & 15) : ((row >> 1) & 7)) << 4)); }
__device__ __forceinline__ int v_st(int k, int c) { const int kk = (k & ~0xC) | ((k & 4) << 1) | ((k & 8) >> 1); return ((kk >> 3) * 4 + (c >> 5)) * 512 + ((kk & 7) * 32 + (c & 31)) * 2; }
__device__ __forceinline__ int v_rd_base(int lane) { return ((lane & 3) << 3) | (((lane >> 2) & 3) << 6) | (((lane >> 4) & 1) << 5) | (((lane >> 5) & 1) << 8); }
constexpr int v_rd_off(int d0, int ks, int half) { return d0 * 512 + ks * 4096 + half * 2048; }
template <int OFF> __device__ __forceinline__ s16x4 tr_read(int vb) { s16x4 r; asm volatile("ds_read_b64_tr_b16 %0, %1 offset:%2" : "=&v"(r) : "v"(vb), "i"(OFF) : "memory"); return r; }
template <int D0> __device__ __forceinline__ void pv_one(f32x16& od, int vb, bf16x8 pa0, bf16x8 pa1, bf16x8 pa2, bf16x8 pa3) {
    const s16x4 l0 = tr_read<v_rd_off(D0, 0, 0)>(vb), h0 = tr_read<v_rd_off(D0, 0, 1)>(vb), l1 = tr_read<v_rd_off(D0, 1, 0)>(vb), h1 = tr_read<v_rd_off(D0, 1, 1)>(vb);
    const s16x4 l2 = tr_read<v_rd_off(D0, 2, 0)>(vb), h2 = tr_read<v_rd_off(D0, 2, 1)>(vb), l3 = tr_read<v_rd_off(D0, 3, 0)>(vb), h3 = tr_read<v_rd_off(D0, 3, 1)>(vb);
    asm volatile("s_waitcnt lgkmcnt(0)" ::: "memory"); SBAR();
#define PK(L, H) (bf16x8){L[0], L[1], L[2], L[3], H[0], H[1], H[2], H[3]}
    od = __builtin_amdgcn_mfma_f32_32x32x16_bf16(pa0, PK(l0, h0), od, 0, 0, 0);
    od = __builtin_amdgcn_mfma_f32_32x32x16_bf16(pa1, PK(l1, h1), od, 0, 0, 0);
    od = __builtin_amdgcn_mfma_f32_32x32x16_bf16(pa2, PK(l2, h2), od, 0, 0, 0);
    od = __builtin_amdgcn_mfma_f32_32x32x16_bf16(pa3, PK(l3, h3), od, 0, 0, 0);
#undef PK
}
template <bool MSUM>
__device__ __forceinline__ void pv_d0(f32x16* o, f32x16& ol, int vb, bf16x8 pa0, bf16x8 pa1, bf16x8 pa2, bf16x8 pa3) {
    if constexpr (MSUM) {
    const bf16x8 ones = {0x3F80, 0x3F80, 0x3F80, 0x3F80, 0x3F80, 0x3F80, 0x3F80, 0x3F80};
    ol = __builtin_amdgcn_mfma_f32_32x32x16_bf16(pa0, ones, ol, 0, 0, 0); ol = __builtin_amdgcn_mfma_f32_32x32x16_bf16(pa1, ones, ol, 0, 0, 0);
    ol = __builtin_amdgcn_mfma_f32_32x32x16_bf16(pa2, ones, ol, 0, 0, 0); ol = __builtin_amdgcn_mfma_f32_32x32x16_bf16(pa3, ones, ol, 0, 0, 0); }
    pv_one<0>(o[0], vb, pa0, pa1, pa2, pa3); pv_one<1>(o[1], vb, pa0, pa1, pa2, pa3); pv_one<2>(o[2], vb, pa0, pa1, pa2, pa3); pv_one<3>(o[3], vb, pa0, pa1, pa2, pa3);
}
template <int DQK, int C> __device__ __forceinline__ void kfrag_load(bf16x8 (&kf)[8], const LAS unsigned char* Ks, int r32, int hi) {
#pragma unroll
    for (int i = 0; i < 4; ++i) { constexpr int d0b = 4 * C; if (d0b + i < DQK / 16) { const int cb = ((d0b + i) * 16 + hi * 8) * 2;
        kf[2 * i] = *(const LAS bf16x8*)(Ks + kswz<DQK>(r32, cb)); kf[2 * i + 1] = *(const LAS bf16x8*)(Ks + kswz<DQK>(32 + r32, cb)); } }
}
template <int DQK, int C> __device__ __forceinline__ void qkt_mma(f32x16& p0, f32x16& p1, const bf16x8 (&kf)[8], const bf16x8* qr) {
#pragma unroll
    for (int i = 0; i < 4; ++i) { constexpr int d0b = 4 * C; if (d0b + i < DQK / 16) {
        p0 = __builtin_amdgcn_mfma_f32_32x32x16_bf16(kf[2 * i], qr[d0b + i], p0, 0, 0, 0);
        p1 = __builtin_amdgcn_mfma_f32_32x32x16_bf16(kf[2 * i + 1], qr[d0b + i], p1, 0, 0, 0); } }
}
template <int DQK> __device__ __forceinline__ void qkt_rest(f32x16& p0, f32x16& p1, bf16x8 (&kfa)[8], const LAS unsigned char* Ks, const bf16x8* qr, int r32, int hi) {
    p0 = f32x16{}; p1 = f32x16{};
    SBAR(); qkt_mma<DQK, 0>(p0, p1, kfa, qr);
    if constexpr (DQK > 64) { SBAR(); kfrag_load<DQK, 1>(kfa, Ks, r32, hi); SBAR(); qkt_mma<DQK, 1>(p0, p1, kfa, qr); }
    if constexpr (DQK > 128) { SBAR(); kfrag_load<DQK, 2>(kfa, Ks, r32, hi); SBAR(); qkt_mma<DQK, 2>(p0, p1, kfa, qr); }
}
template <bool PRESCALED>
__device__ __forceinline__ void partialSM(f32x16& p0, f32x16& p1, float& m_reg, float& alpha, float C) {
    float pmax = p0[0];
#pragma unroll
    for (int r = 1; r < 16; ++r) pmax = fmaxf(pmax, p0[r]);
#pragma unroll
    for (int r = 0; r < 16; ++r) pmax = fmaxf(pmax, p1[r]);
    { auto rr = __builtin_amdgcn_permlane32_swap(__float_as_uint(pmax), __float_as_uint(pmax), false, false);
      pmax = fmaxf(__uint_as_float(rr[0]), __uint_as_float(rr[1])); }
    if (!PRESCALED) pmax *= C;
    float mn;
    if (__builtin_expect(__all(pmax - m_reg <= THR2), 1)) { mn = m_reg; alpha = 1.f; }
    else { mn = fmaxf(m_reg, pmax); alpha = __builtin_amdgcn_exp2f(m_reg - mn); m_reg = mn; }
    if (PRESCALED) {
#pragma unroll
        for (int r = 0; r < 16; ++r) { p0[r] -= mn; p1[r] -= mn; }
    } else { const float nm = -mn;
#pragma unroll
        for (int r = 0; r < 16; ++r) { p0[r] = fmaf(p0[r], C, nm); p1[r] = fmaf(p1[r], C, nm); } }
#pragma unroll
    for (int r = 0; r < 16; ++r) p0[r] = __builtin_amdgcn_exp2f(p0[r]);
}
template <bool MSUM>
__device__ __forceinline__ void finishSM(f32x16& p0, f32x16& p1, float alpha, float& l_reg, bf16x8& pa0, bf16x8& pa1, bf16x8& pa2, bf16x8& pa3) {
#pragma unroll
    for (int r = 0; r < 16; ++r) p1[r] = __builtin_amdgcn_exp2f(p1[r]);
    if constexpr (!MSUM) { float ps = 0;
#pragma unroll
        for (int r = 0; r < 16; ++r) ps += p0[r];
#pragma unroll
        for (int r = 0; r < 16; ++r) ps += p1[r];
        { auto rr = __builtin_amdgcn_permlane32_swap(__float_as_uint(ps), __float_as_uint(ps), false, false);
          ps = __uint_as_float(rr[0]) + __uint_as_float(rr[1]); }
        l_reg = l_reg * alpha + ps; }
#define PK4(P, BASE, OUT) do { unsigned a0 = cvtpk(P[BASE + 0], P[BASE + 1]), a1 = cvtpk(P[BASE + 2], P[BASE + 3]);   \
    unsigned b0 = cvtpk(P[BASE + 4], P[BASE + 5]), b1 = cvtpk(P[BASE + 6], P[BASE + 7]);                              \
    auto r0 = __builtin_amdgcn_permlane32_swap(a0, b0, false, false); auto r1 = __builtin_amdgcn_permlane32_swap(a1, b1, false, false); \
    u32x4 w = {r0[0], r1[0], r0[1], r1[1]}; OUT = __builtin_bit_cast(bf16x8, w); } while (0)
    PK4(p0, 0, pa0); PK4(p0, 8, pa1); PK4(p1, 0, pa2); PK4(p1, 8, pa3);
#undef PK4
}
struct AttnP { const bf16* Q; const bf16* K; const bf16* V; bf16* O; float C; const u64* mask; const float* cum; const bf16* gate; float lam, oscale; const float* subg; float* O1; };
template <int QRS_, int QHS_, int KRS_, int KHS_, int VRS_, int VHS_, int GRS_> struct Strides { static constexpr int q_rs = QRS_, q_hs = QHS_, k_rs = KRS_, k_hs = KHS_, v_rs = VRS_, v_hs = VHS_, g_rs = GRS_; };
template <int MODE, int DQK, class ST>
__device__ __forceinline__ void attn_unit(const AttnP& A, const int h, const int qb, LAS unsigned char* lds, const int wave) {
    constexpr int SHM_V = 64 * 128 * 2, SHM_K = 64 * DQK * 2, CPR = DQK / 8, KCH = DQK / 64, RING = 3 * SHM_V + 3 * SHM_K;
    const int tid = tid_of(wave), wid = wave,
    lane_m = tid & 63, r32_m = lane_m & 31, hi_m = lane_m >> 5;
    LAS unsigned char* V_lds = lds; LAS unsigned char* K_lds = lds + 3 * SHM_V;
    LAS float* wsf = (LAS float*)(lds + RING) + wid * 64; LAS float* li_l = wsf; LAS float* al_l = wsf + 32;
    LAS float* cumL = (LAS float*)(lds + RING + 2048);
    static_assert(RING + 2048 + (MODE == 3 ? 32768 : 0) <= MISC_OFF, "attention LDS map");
    const int q0 = qb * 256, NT = (q0 + 256) / 64, qrow_m = q0 + wid * 32 + r32_m;
    float cq2 = 0.f;
    if (MODE == 3) {
#pragma unroll 1
        for (int i = tid; i < (q0 + 256) / 4; i += 512) *(LAS f32x4*)(cumL + 4 * i) = *(const f32x4*)(A.cum + (size_t)h * S + 4 * i);
        __syncthreads(); cq2 = cumL[qrow_m]; }
#pragma unroll 1
    for (int pass = 0; pass < (MODE == 2 ? 2 : 1); ++pass) {
    const int qh = MODE == 2 ? 2 * h + pass : h;
    const bf16* Kh = A.K + qh * ST::k_hs; const bf16* Vh = A.V + h * ST::v_hs;
    constexpr bool MSUM = DQK <= 128;
    float l_reg = 0.f; f32x16 o[4] = {}; f32x16 ol = {};
    {
    const int lane = lane_m, r32 = r32_m, hi = hi_m, qrow = qrow_m; float m_reg = -1e30f; bf16x8 qr[DQK / 16];
    { const bf16* Qw = A.Q + (size_t)qrow * ST::q_rs + qh * ST::q_hs + hi * 8;
#pragma unroll
      for (int d0 = 0; d0 < DQK / 16; ++d0) qr[d0] = *(const bf16x8*)(Qw + d0 * 16); }
    const int sr = tid >> 4, sc = (tid & 15) * 8, vst0 = v_st(sr, sc), vst1 = v_st(32 + sr, sc);
    unsigned kgo[KCH]; int klo[KCH];
#pragma unroll
    for (int i = 0; i < KCH; ++i) { const int q = tid + 512 * i, row = q / CPR, ch = q % CPR; kgo[i] = (unsigned)(row * ST::k_rs + ch * 8); klo[i] = kswz<DQK>(row, ch * 16); }
    const unsigned vgo0 = (unsigned)(sr * ST::v_rs + sc), vgo1 = (unsigned)((32 + sr) * ST::v_rs + sc);
    const int vb0 = (int)(unsigned)(uintptr_t)V_lds + v_rd_base(lane);
    struct { bf16x8 vs0, vs1; bf16x8 ks[KCH]; } sr_[1];
#define SLOAD(i, k0) do { const bf16* vb_ = Vh + (size_t)(k0) * ST::v_rs; const bf16* kb_ = Kh + (size_t)(k0) * ST::k_rs; \
    sr_[i].vs0 = *(const bf16x8*)(vb_ + vgo0); sr_[i].vs1 = *(const bf16x8*)(vb_ + vgo1); \
    _Pragma("unroll") for (int _k = 0; _k < KCH; ++_k) sr_[i].ks[_k] = *(const bf16x8*)(kb_ + kgo[_k]); } while (0)
#define SWRITE(b, i) do { *(LAS bf16x8*)(V_lds + (b) * SHM_V + vst0) = sr_[i].vs0; *(LAS bf16x8*)(V_lds + (b) * SHM_V + vst1) = sr_[i].vs1; \
    _Pragma("unroll") for (int _k = 0; _k < KCH; ++_k) *(LAS bf16x8*)(K_lds + (b) * SHM_K + klo[_k]) = sr_[i].ks[_k]; } while (0)
#define SWAIT() asm volatile("s_waitcnt vmcnt(0)" ::: "memory")
#define BAR() asm volatile("s_waitcnt lgkmcnt(0)\n\ts_barrier" ::: "memory")
#define RESC(a) do { if (__any((a) < 1.f)) { int l_; asm volatile("v_mbcnt_lo_u32_b32 %0, -1, 0\n\tv_mbcnt_hi_u32_b32 %0, -1, %0" : "=v"(l_));   \
    if (l_ < 32) al_l[l_] = (a); asm volatile("s_waitcnt lgkmcnt(0)" ::: "memory"); const int h_ = l_ >> 5; \
    _Pragma("unroll") for (int r = 0; r < 16; ++r) { const float f_ = al_l[crow(r, h_)]; if (MSUM) ol[r] *= f_; _Pragma("unroll") for (int d = 0; d < 4; ++d) o[d][r] *= f_; } } } while (0)
    int mG = -1; u64 mw0 = 0, mw1 = 0, mw2 = 0, mw3 = 0;
    u32x4 nx0, nx1;
    { const u32x4* mp = (const u32x4*)((MODE == 1 ? A.mask : (const u64*)A.Q) + (MODE == 1 ? (size_t)qrow * 128 : 0)); nx0 = mp[0]; nx1 = mp[1]; }
#define FIX(P0, P1, T) do { \
    if (MODE == 0 || MODE == 2 || MODE == 3) { if (MODE == 3) { const LAS float* cl = cumL + (T) * 64 + 4 * hi; \
            _Pragma("unroll") for (int jj = 0; jj < 4; ++jj) { const f32x4 c0 = *(const LAS f32x4*)(cl + 8 * jj), c1 = *(const LAS f32x4*)(cl + 32 + 8 * jj); \
                _Pragma("unroll") for (int i = 0; i < 4; ++i) { P0[4 * jj + i] = fmaf(P0[4 * jj + i], A.C, cq2 - c0[i]); P1[4 * jj + i] = fmaf(P1[4 * jj + i], A.C, cq2 - c1[i]); } SBAR(); } } \
        if ((T) >= NT - 4) { const int kb = 64 * ((T) - (NT - 4)) + 4 * hi, qrel = wid * 32 + r32; \
            _Pragma("unroll") for (int r = 0; r < 16; ++r) { const int kv = kb + (r & 3) + 8 * (r >> 2); if (kv > qrel) P0[r] = -INFINITY; if (kv + 32 > qrel) P1[r] = -INFINITY; } } } \
    if (MODE == 1) { if (((T) >> 2) != mG) { mG = (T) >> 2;             \
            mw0 = (u64)nx0.x | ((u64)nx0.y << 32); mw1 = (u64)nx0.z | ((u64)nx0.w << 32); mw2 = (u64)nx1.x | ((u64)nx1.y << 32); mw3 = (u64)nx1.z | ((u64)nx1.w << 32); \
            { const int gn_ = 4 * (mG + 1) < NT ? mG + 1 : mG; const u32x4* mp = (const u32x4*)(A.mask + ((size_t)qrow * 32 + gn_) * 4); nx0 = mp[0]; nx1 = mp[1]; } } \
        const int sh = 16 * ((T) & 3) + hi; const unsigned b0 = (unsigned)(mw0 >> sh), b1 = (unsigned)(mw1 >> sh), b2 = (unsigned)(mw2 >> sh), b3 = (unsigned)(mw3 >> sh); \
        _Pragma("unroll") for (int jj = 0; jj < 4; ++jj) { \
            if (!((b0 >> (2 * jj)) & 1u)) P0[4 * jj + 0] = -INFINITY; if (!((b1 >> (2 * jj)) & 1u)) P0[4 * jj + 1] = -INFINITY; \
            if (!((b2 >> (2 * jj)) & 1u)) P0[4 * jj + 2] = -INFINITY; if (!((b3 >> (2 * jj)) & 1u)) P0[4 * jj + 3] = -INFINITY; \
            if (!((b0 >> (8 + 2 * jj)) & 1u)) P1[4 * jj + 0] = -INFINITY; if (!((b1 >> (8 + 2 * jj)) & 1u)) P1[4 * jj + 1] = -INFINITY; \
            if (!((b2 >> (8 + 2 * jj)) & 1u)) P1[4 * jj + 2] = -INFINITY; if (!((b3 >> (8 + 2 * jj)) & 1u)) P1[4 * jj + 3] = -INFINITY; } } } while (0)
    constexpr bool PRE = (MODE == 3);
    {
        const int grp = wid >> 2;
        f32x16 p0, p1; float al = 1.f; bf16x8 pa0, pa1, pa2, pa3;
        SLOAD(0, 0); SWAIT(); SWRITE(0, 0); SLOAD(0, 64); BAR();
        if (grp == 1) BAR();
        bf16x8 kfa[8];
        SWAIT(); SWRITE(1, 0); kfrag_load<DQK, 0>(kfa, K_lds, r32, hi); SBAR(); qkt_rest<DQK>(p0, p1, kfa, K_lds, qr, r32, hi); BAR();
        int s_prev = 0, s_cur = 1, s_next = 2;
#pragma unroll 1
        for (int m = 1; m < NT; ++m) {
            if (m + 1 < NT) SLOAD(0, (m + 1) * 64);
            SBAR(); FIX(p0, p1, m - 1); partialSM<PRE>(p0, p1, m_reg, al, A.C); finishSM<MSUM>(p0, p1, al, l_reg, pa0, pa1, pa2, pa3); BAR();
            if (m + 1 < NT) { SWAIT(); SWRITE(s_next, 0); }
            kfrag_load<DQK, 0>(kfa, K_lds + s_cur * SHM_K, r32, hi);
            RESC(al); SBAR();
            pv_d0<MSUM>(o, ol, vb0 + s_prev * SHM_V, pa0, pa1, pa2, pa3); SBAR();
            qkt_rest<DQK>(p0, p1, kfa, K_lds + s_cur * SHM_K, qr, r32, hi); BAR();
            { const int t_ = s_prev; s_prev = s_cur; s_cur = s_next; s_next = t_; }
        }
        SBAR(); FIX(p0, p1, NT - 1); partialSM<PRE>(p0, p1, m_reg, al, A.C); finishSM<MSUM>(p0, p1, al, l_reg, pa0, pa1, pa2, pa3); BAR();
        RESC(al); SBAR();
        pv_d0<MSUM>(o, ol, vb0 + s_prev * SHM_V, pa0, pa1, pa2, pa3);
        if (grp == 0) BAR();
    }
    }
    asm volatile("s_waitcnt vmcnt(0)" ::: "memory");
    int lane_e; asm volatile("v_mbcnt_lo_u32_b32 %0, -1, 0\n\tv_mbcnt_hi_u32_b32 %0, -1, %0" : "=v"(lane_e));
    const int r32 = lane_e & 31, hi = lane_e >> 5, lane = lane_e;
    float rli[16];
    if constexpr (MSUM) {
#pragma unroll
        for (int r = 0; r < 16; ++r) rli[r] = __builtin_amdgcn_rcpf(ol[r]);
    } else { if (hi == 0) li_l[r32] = l_reg; asm volatile("s_waitcnt lgkmcnt(0)" ::: "memory");
#pragma unroll
        for (int r = 0; r < 16; ++r) rli[r] = __builtin_amdgcn_rcpf(li_l[crow(r, hi)]); }
#pragma unroll
    for (int d0 = 0; d0 < 4; ++d0)
#pragma unroll
        for (int r = 0; r < 16; ++r) o[d0][r] *= rli[r];
    if (MODE == 2 && pass == 0) {
        float* Ow = A.O1 + (size_t)(q0 + wid * 32) * D + h * 128;
#pragma unroll
        for (int r = 0; r < 16; ++r)
#pragma unroll
            for (int d0 = 0; d0 < 4; ++d0) Ow[(size_t)crow(r, hi) * D + d0 * 32 + r32] = o[d0][r];
        asm volatile("s_waitcnt vmcnt(0)" ::: "memory"); __syncthreads();
        continue;
    }
    if (MODE == 2) {
        const float* Ow = A.O1 + (size_t)(q0 + wid * 32) * D + h * 128;
#pragma unroll
        for (int r = 0; r < 16; ++r) { float ss = 0.f;
#pragma unroll
            for (int d0 = 0; d0 < 4; ++d0) { const float v = Ow[(size_t)crow(r, hi) * D + d0 * 32 + r32] - A.lam * o[d0][r]; o[d0][r] = v; ss += v * v; }
#pragma unroll
            for (int off = 16; off >= 1; off >>= 1) ss += __shfl_xor(ss, off);
            const float rs = rsqrtf(ss * (1.f / 128.f) + EPS) * A.oscale;
#pragma unroll
            for (int d0 = 0; d0 < 4; ++d0) o[d0][r] *= rs * A.subg[d0 * 32 + r32]; }
    }
    __syncthreads();
    { LAS unsigned char* stg = lds + wid * (32 * 272);
#pragma unroll
      for (int r = 0; r < 16; ++r)
#pragma unroll
          for (int d0 = 0; d0 < 4; ++d0) *(LAS unsigned short*)(stg + crow(r, hi) * 272 + (d0 * 32 + r32) * 2) = (unsigned short)f2bf(o[d0][r]);
      asm volatile("s_waitcnt lgkmcnt(0)" ::: "memory");
#pragma unroll
      for (int i = 0; i < 8; ++i) { const int row = i * 4 + (lane >> 4), ch = lane & 15; u32x4 v = *(const LAS u32x4*)(stg + row * 272 + ch * 16);
          const size_t grow = (size_t)(q0 + wid * 32 + row);
          if (MODE == 3) { const u32x4 gv = *(const u32x4*)(A.gate + grow * ST::g_rs + h * 128 + ch * 8);
#pragma unroll
              for (int e = 0; e < 4; ++e) { const float g0 = bf2f(gv[e] & 0xffffu), g1 = bf2f(gv[e] >> 16), x0 = bf2f(v[e] & 0xffffu), x1 = bf2f(v[e] >> 16);
                  v[e] = pk2(x0 * __builtin_amdgcn_rcpf(1.f + __expf(-g0)), x1 * __builtin_amdgcn_rcpf(1.f + __expf(-g1))); } }
          *(u32x4*)(A.O + grow * D + h * 128 + ch * 8) = v; } }
    asm volatile("s_waitcnt vmcnt(0) lgkmcnt(0)" ::: "memory"); __syncthreads();
    }
#undef SLOAD
#undef SWRITE
#undef SWAIT
#undef BAR
#undef RESC
#undef FIX
}
template <int MODE, int DQK, class ST>
__device__ __forceinline__ void attn_phase(const AttnP& A, LAS unsigned char* lds, int blk, int G, int wave) {
    const int vcu = (G % 8 == 0) ? (blk % 8) * (G / 8) + blk / 8 : blk;
    for (int p = vcu; p < 256; p += G) { const int h = p >> 4, s2 = p & 15;
        attn_unit<MODE, DQK, ST>(A, h, 31 - s2, lds, wave); attn_unit<MODE, DQK, ST>(A, h, s2, lds, wave); }
}
#undef SBAR
}

__device__ __forceinline__ void score_mfma(const bf16* P, const float* IW, float* SIDX, const Ctx& c) {
#pragma unroll 1
    for (int task = c.gw; task < 2304; task += c.ngw) {
        int lane = c.lane; asm volatile("" : "+v"(lane));
        const int l16 = lane & 15, kg = lane >> 4;
        int j = 0;
#pragma unroll
        for (int jj = 1; jj < 8; ++jj) if (task >= 32 * jj * (jj + 1)) j = jj;
        const int local = task - 32 * j * (j + 1), qg = 64 * j + local / (j + 1), kc = local % (j + 1), t0 = 16 * qg;
        const bf16* qp = P + (size_t)(t0 + l16) * N_DSA_IN + 6144 + 8 * kg;
        bf16x8 bq[16][2]; float w[16];
#pragma unroll
        for (int h = 0; h < 16; ++h) { bq[h][0] = *(const bf16x8*)(qp + h * 64); bq[h][1] = *(const bf16x8*)(qp + h * 64 + 32); w[h] = IW[(t0 + l16) * 16 + h] * 0.0625f; }
        bf16x8 bl[2];
#pragma unroll
        for (int u2 = 0; u2 < 2; ++u2) { float sacc[8] = {0.f, 0.f, 0.f, 0.f, 0.f, 0.f, 0.f, 0.f};
#pragma unroll
            for (int h = 0; h < 16; ++h)
#pragma unroll
                for (int e = 0; e < 8; ++e) sacc[e] += w[h] * bf2f((unsigned short)bq[h][u2][e]);
            u32x4 pk; pk.x = pk2(sacc[0], sacc[1]); pk.y = pk2(sacc[2], sacc[3]); pk.z = pk2(sacc[4], sacc[5]); pk.w = pk2(sacc[6], sacc[7]); bl[u2] = __builtin_bit_cast(bf16x8, pk); }
        const int kend = (1024 * kc + 1024) < (t0 + 16) ? (1024 * kc + 1024) : (t0 + 16);
        const bf16* kp = P + (size_t)(1024 * kc + l16) * N_DSA_IN + 7168 + 8 * kg;
        float* op = SIDX + (size_t)(t0 + l16) * S + 1024 * kc + 4 * kg;
        bf16x8 a0 = *(const bf16x8*)kp, a1 = *(const bf16x8*)(kp + 32);
        for (int k0 = 1024 * kc; k0 < kend; k0 += 16) {
            const bf16x8 c0 = a0, c1 = a1;
            if (k0 + 16 < kend) { kp += (size_t)16 * N_DSA_IN; a0 = *(const bf16x8*)kp; a1 = *(const bf16x8*)(kp + 32); }
            f32x4 acc = {0.f, 0.f, 0.f, 0.f};
            acc = __builtin_amdgcn_mfma_f32_16x16x32_bf16(c0, bl[0], acc, 0, 0, 0);
            acc = __builtin_amdgcn_mfma_f32_16x16x32_bf16(c1, bl[1], acc, 0, 0, 0);
            f32x4 dc = {0.f, 0.f, 0.f, 0.f}, dm = {0.f, 0.f, 0.f, 0.f};
            dc = __builtin_amdgcn_mfma_f32_16x16x32_bf16(c0, bq[0][0], dc, 0, 0, 0); dm = __builtin_amdgcn_mfma_f32_16x16x32_bf16(c0, bq[1][0], dm, 0, 0, 0);
            dc = __builtin_amdgcn_mfma_f32_16x16x32_bf16(c1, bq[0][1], dc, 0, 0, 0); dm = __builtin_amdgcn_mfma_f32_16x16x32_bf16(c1, bq[1][1], dm, 0, 0, 0);
#pragma unroll
            for (int h = 0; h < 16; ++h) { f32x4 dn = {0.f, 0.f, 0.f, 0.f};
                if (h + 2 < 16) { dn = __builtin_amdgcn_mfma_f32_16x16x32_bf16(c0, bq[h + 2 < 16 ? h + 2 : 15][0], dn, 0, 0, 0);
                                  dn = __builtin_amdgcn_mfma_f32_16x16x32_bf16(c1, bq[h + 2 < 16 ? h + 2 : 15][1], dn, 0, 0, 0); }
                else asm volatile("s_nop 7\n\ts_nop 7\n\ts_nop 7" ::: "memory");
                if (h == 0) { __builtin_amdgcn_sched_barrier(0); asm volatile("s_nop 7\n\ts_nop 7\n\ts_nop 7" ::: "memory"); }
                __builtin_amdgcn_sched_barrier(0);
#pragma unroll
                for (int i = 0; i < 4; ++i) asm volatile("v_fma_f32 %0, %1, |%2|, %0" : "+v"(acc[i]) : "v"(w[h]), "v"(dc[i]));
                __builtin_amdgcn_sched_barrier(0);
                dc = dm; dm = dn; }
            *(f32x4*)op = acc; op += 16;
        }
    }
}
__device__ __forceinline__ void select_phase(const float* SIDX, u64* MASK, const Ctx& c) {
    const int q4 = c.tid >> 7, t128 = c.tid & 127, w2 = t128 >> 6, lane = c.lane;
    LAS unsigned* hist = (LAS unsigned*)(c.lds + q4 * 16384);
    volatile LAS unsigned* wt = (volatile LAS unsigned*)(c.lds + 65536 + q4 * 64);
    u32x4 nv[16];
    { const int t0_ = 4 * c.blk + q4;
#pragma unroll
      for (int j = 0; j < 16; ++j) { const int base = 512 * j + 4 * t128; nv[j] = *(const u32x4*)(SIDX + (size_t)t0_ * S + (base <= t0_ ? base : 0)); } }
#pragma unroll 1
    for (int grp = c.blk; grp < S / 4; grp += c.G) {
        const int t = 4 * grp + q4;
        unsigned u[64];
#pragma unroll
        for (int j = 0; j < 16; ++j) { const int base = 512 * j + 4 * t128;
            const u32x4 v = nv[j];
#pragma unroll
            for (int e = 0; e < 4; ++e) { const unsigned b = v[e]; const unsigned o = (b & 0x80000000u) ? ~b : (b | 0x80000000u);
                u[4 * j + e] = (base + e <= t) ? o : 0u; } }
        { const int gn_ = grp + c.G < S / 4 ? grp + c.G : grp; const int tn_ = 4 * gn_ + q4;
#pragma unroll
          for (int j = 0; j < 16; ++j) { const int base = 512 * j + 4 * t128; nv[j] = *(const u32x4*)(SIDX + (size_t)tn_ * S + (base <= tn_ ? base : 0)); } }
        unsigned krem = (unsigned)(t + 1 < 256 ? t + 1 : 256), prefix = 0u;
        unsigned lmin;
        { unsigned m1 = 0u, m2 = 0u;
#pragma unroll
          for (int i = 0; i < 64; ++i) { const unsigned lo = u[i] < m1 ? u[i] : m1; m2 = lo > m2 ? lo : m2; m1 = u[i] > m1 ? u[i] : m1; }
          unsigned lm = m2;
#pragma unroll
          for (int o = 32; o >= 1; o >>= 1) { const unsigned n = __shfl_xor(lm, o); lm = n < lm ? n : lm; }
          if (lane == 0) wt[12 + w2] = lm;
          __syncthreads();
          lmin = wt[12]; { const unsigned a1 = wt[13]; lmin = a1 < lmin ? a1 : lmin; } }
#pragma unroll
        for (int pass = 0; pass < 3; ++pass) {
            const int shift = pass == 0 ? 20 : (pass == 1 ? 8 : 0); const unsigned dmask = pass == 2 ? 0xFFu : 0xFFFu;
            const int pshift = pass == 0 ? 32 : (pass == 1 ? 20 : 8);
#pragma unroll
            for (int i = 0; i < 32; ++i) hist[t128 + 128 * i] = 0u;
            __syncthreads();
#pragma unroll
            for (int i = 0; i < 64; ++i) { const bool match = pass == 0 ? (u[i] >= lmin && u[i] != 0u) : ((u[i] >> pshift) == prefix && u[i] >= lmin);
                if (match) atomicAdd((unsigned*)&hist[(u[i] >> shift) & dmask], 1u); }
            __syncthreads();
            unsigned loc = 0u;
#pragma unroll
            for (int i = 0; i < 32; ++i) loc += hist[32 * t128 + i];
            unsigned incl = loc;
#pragma unroll
            for (int o = 1; o < 64; o <<= 1) { const unsigned n = __shfl_down(incl, o); if (lane + o < 64) incl += n; }
            if (lane == 0) wt[w2] = incl;
            __syncthreads();
            const unsigned above = w2 == 0 ? wt[1] : 0u;
            incl += above; const unsigned excl = incl - loc;
            if (excl < krem && krem <= incl) { unsigned cnt = excl;
                for (int b = 31; b >= 0; --b) { const unsigned hb = hist[32 * t128 + b];
                    if (cnt + hb >= krem) { wt[8] = (unsigned)(32 * t128 + b); wt[9] = krem - cnt; break; } cnt += hb; } }
            __syncthreads();
            prefix = (pass == 0) ? wt[8] : (pass == 1 ? ((prefix << 12) | wt[8]) : ((prefix << 8) | wt[8]));
            krem = wt[9];
        }
        const unsigned thr = prefix;
#pragma unroll
        for (int j = 0; j < 16; ++j) { if (512 * j <= t) {
#pragma unroll
            for (int e = 0; e < 4; ++e) { const u64 bal = __ballot(u[4 * j + e] >= thr && u[4 * j + e] != 0u);
                if (lane == 0) MASK[((size_t)t * 32 + (2 * j + w2)) * 4 + e] = bal; } } }
        __syncthreads();
    }
}


__device__ __forceinline__ void ph_cumsum(const float* logf, float* cum, const Ctx& c) {
    if (c.blk >= NH) return;
    LAS float* wsum = (LAS float*)c.lds; const int h = c.blk, tid = c.tid;
    float v[16];
    { const f32x4* lp = (const f32x4*)(logf + (size_t)h * S + 16 * tid);
#pragma unroll
      for (int k = 0; k < 4; ++k) { const f32x4 x = lp[k]; v[4 * k] = x.x; v[4 * k + 1] = x.y; v[4 * k + 2] = x.z; v[4 * k + 3] = x.w; } }
#pragma unroll
    for (int k = 1; k < 16; ++k) v[k] += v[k - 1];
    const float tot = v[15]; float incl = tot;
#pragma unroll
    for (int o2 = 1; o2 < 64; o2 <<= 1) { const float nb = __shfl_up(incl, o2); if (c.lane >= o2) incl += nb; }
    if (c.lane == 63) wsum[c.wave] = incl;
    __syncthreads();
    float base = incl - tot;
    for (int w = 0; w < c.wave; ++w) base += wsum[w];
    f32x4* op = (f32x4*)(cum + (size_t)h * S + 16 * tid);
#pragma unroll
    for (int k = 0; k < 4; ++k) op[k] = (f32x4){(v[4 * k] + base) * fa::LOG2E, (v[4 * k + 1] + base) * fa::LOG2E, (v[4 * k + 2] + base) * fa::LOG2E, (v[4 * k + 3] + base) * fa::LOG2E};
}
constexpr int NPHASE = 32;
#ifndef MK_PER_PHASE
#define MK_PER_PHASE 0
#endif
__global__ void __launch_bounds__(512, 2) mega(Args a) {
    extern __shared__ __attribute__((aligned(16))) unsigned char lds_raw[];
    Ctx c; c.lds = (LAS unsigned char*)lds_raw; c.tid = threadIdx.x; c.lane = c.tid & 63; c.wave = __builtin_amdgcn_readfirstlane(c.tid >> 6);
    c.G = gridDim.x; c.blk = blockIdx.x; c.gw = c.blk * 8 + c.wave; c.ngw = c.G * 8;
    volatile LAS unsigned* MISC = (volatile LAS unsigned*)(c.lds + MISC_OFF);
    if (c.tid < 32) MISC[c.tid] = 0u;
    __syncthreads();
    unsigned* ctl = (unsigned*)(a.ws + WS_CTL);
    XcdBarrier bar; bar.bar = ctl + CW_BAR; bar.x = 0; bar.st = nullptr; bar.wave = c.wave;
    const int lo = a.ph_lo, hi = a.ph_hi;
    if (hi - lo > 1) bar = xcd_barrier_post(ctl + CW_BAR, MISC + 8, c.wave);
#define IN(k) (lo <= (k) && (k) < hi && (fresh(c), ws = launder_ptr(a.ws), true))
#define SEAM(k) do { if (lo <= (k) && (k) + 1 < hi) xcd_barrier(bar); } while (0)
    unsigned char* ws = a.ws;
#define mod ((float*)(ws + WS_MOD))
#define XB ((bf16*)(ws + WS_XB))
#define P ((bf16*)(ws + WS_P))
#define Ob ((bf16*)(ws + WS_O))
#define HID ((bf16*)(ws + WS_HID))
#define STAT ((float*)(ws + WS_STAT))
#define BIAS ((float*)(ws + WS_BIAS))
#define BIASP ((const float*)(ws + WS_BIASP))
#define xin ((const float*)a.in[I_X])
#define out (a.out)
#define R64 ((const f32x2*)(ws + WS_ROPE64))
#define R32 ((const f32x2*)(ws + WS_ROPE32))
#define R16 ((const f32x2*)(ws + WS_ROPE16))
#define PM ((bf16*)(ws + WS_PM))
#define CN ((bf16*)(ws + WS_CN))
#define QRAW P
#define KVRAW ((bf16*)(ws + WS_P + 48 * MiB))
#define Qb ((bf16*)(ws + WS_Q))
#define Kb ((bf16*)(ws + WS_K))
#define IW ((float*)(ws + WS_IW))
#define SIDX ((float*)(ws + WS_SIDX))
#define MASK ((u64*)(ws + WS_MASK))
#define LOGF ((float*)(ws + WS_LOGF))

    if (IN(0)) ph_phase0(a, c);
    SEAM(0);
    if (IN(1)) ph_modfinal(a, c);
    SEAM(1);
    if (IN(2)) ph_weights(a, c);
    SEAM(2);

#define WIN(PH, WOFF, NN, BO, OUTP, NHT) \
    if (IN(PH)) { if ((PH) == 3) { bias_all(BIASP, BIAS, N_MLA_IN, c); bias_reduce(BIASP + (BO), BIAS + (BO), S, NN, c.G, c.blk, c.wave, NHT); } pg8::EpiStoreP EP{OUTP, NN, STAT, BIAS + (BO)}; GEMM_SITE(EP, XB, D, (const bf16*)(ws + (WOFF)), D, S, NN, D, NHT); } \
    SEAM(PH);
#define WOUT(L, PH, XSRC) \
    if (IN(PH)) { pg8::EpiResP<false> EP{XB, (bf16*)(ws + WS_XL), mod + (L) * NMOD + 2 * D, STAT, nullptr}; GEMM_SITE(EP, Ob, D, (const bf16*)(ws + WS_W_OUT + (size_t)(L) * 8 * MiB), D, S, D, D, 0); } \
    SEAM(PH);
#define FFN_PHASES(L, P0) \
    if (IN(P0)) { pg8::EpiSwigluP EP{HID, STAT, BIAS + BO_GU + (L) * 2 * FF}; \
        GEMM_SITE(EP, XB, D, (const bf16*)(ws + WS_W_GU + (size_t)(L) * 44 * MiB), D, S, 2 * FF, D, 4); } \
    SEAM(P0); \
    if (IN(P0 + 1)) { pg8::EpiResP<(L) == 3> EP{XB, (bf16*)(ws + WS_XL), mod + (L) * NMOD + 5 * D, STAT, out}; GEMM_SITE(EP, HID, FF, (const bf16*)(ws + WS_W_DN + (size_t)(L) * 22 * MiB), FF, S, D, FF, 0); } \
    if ((P0) + 1 < NPHASE - 1) SEAM(P0 + 1);

    WIN(3, WS_W_MLA_IN, N_MLA_IN, BO_MLA, PM, 0)
    if (IN(4)) {
        const float* gq = (const float*)a.in[I_MLA_QAG]; const float* gkv = (const float*)a.in[I_MLA_KVAG];
        const int hf = c.lane >> 5, l32 = c.lane & 31;
        float g[16];
        { const float* gp = (hf ? gkv : gq) + l32 * 16;
#pragma unroll
          for (int e = 0; e < 4; ++e) { const f32x4 gv = *(const f32x4*)(gp + 4 * e); g[4 * e] = gv.x; g[4 * e + 1] = gv.y; g[4 * e + 2] = gv.z; g[4 * e + 3] = gv.w; } }
        bf16x8 n0, n1;
        { const bf16* src = PM + (size_t)(c.gw < S ? c.gw : 0) * N_MLA_IN + hf * 512 + l32 * 16; n0 = *(const bf16x8*)src; n1 = *(const bf16x8*)(src + 8); }
        for (int t = c.gw; t < S; t += c.ngw) {
            const bf16x8 v0 = n0, v1 = n1; float x[16]; float ss = 0.f;
            { const int tn = t + c.ngw < S ? t + c.ngw : t; const bf16* src = PM + (size_t)tn * N_MLA_IN + hf * 512 + l32 * 16; n0 = *(const bf16x8*)src; n1 = *(const bf16x8*)(src + 8); }
#pragma unroll
            for (int e = 0; e < 8; ++e) { x[e] = bf2f((unsigned short)v0[e]); x[8 + e] = bf2f((unsigned short)v1[e]); }
#pragma unroll
            for (int e = 0; e < 16; ++e) ss += x[e] * x[e];
#pragma unroll
            for (int o = 16; o >= 1; o >>= 1) ss += __shfl_xor(ss, o);
            const float r = rsqrtf(ss * (1.f / 512.f) + EPS);
            u32x4 o0, o1;
            o0.x = pk2(x[0] * r * g[0], x[1] * r * g[1]); o0.y = pk2(x[2] * r * g[2], x[3] * r * g[3]); o0.z = pk2(x[4] * r * g[4], x[5] * r * g[5]); o0.w = pk2(x[6] * r * g[6], x[7] * r * g[7]);
            o1.x = pk2(x[8] * r * g[8], x[9] * r * g[9]); o1.y = pk2(x[10] * r * g[10], x[11] * r * g[11]); o1.z = pk2(x[12] * r * g[12], x[13] * r * g[13]); o1.w = pk2(x[14] * r * g[14], x[15] * r * g[15]);
            bf16* dst = CN + (size_t)t * 1024 + hf * 512 + l32 * 16; *(u32x4*)dst = o0; *(u32x4*)(dst + 8) = o1;
        }
    }
    SEAM(4);
    if (IN(5)) {
        { pg8::EpiStoreP EP{QRAW, 3072, nullptr, nullptr}; GEMM_SITE(EP, CN, 1024, (const bf16*)(ws + WS_W_MLA_QB), 512, S, 3072, 512, 4); }
        { pg8::EpiStoreP EP{KVRAW, 4096, nullptr, nullptr}; GEMM_SITE(EP, CN + 512, 1024, (const bf16*)(ws + WS_W_MLA_KVB), 512, S, 4096, 512, 0); }
    }
    SEAM(5);
    if (IN(6)) {
        const float* gq = (const float*)a.in[I_MLA_QG]; const float* gk = (const float*)a.in[I_MLA_KG];
        const int hl = c.lane >> 3, part = c.lane & 7;
        H8G<192> Gq, Gk; h8_gain<192>(Gq, gq, part); h8_gain<192>(Gk, gk, part);
        H8R<192> nq, nk; H8C nc;
#define MLA_LOAD(IT) do { const int t_ = (IT) >> 1, h_ = ((IT) & 1) * 8 + hl; const bf16* qs_ = QRAW + (size_t)t_ * 3072 + h_ * 192 + part * 8; \
            h8_load<192>(nq, qs_, qs_ + 64); h8_load<192>(nk, PM + (size_t)t_ * N_MLA_IN + 1024 + part * 8, KVRAW + (size_t)t_ * 4096 + h_ * 256 + part * 8); h8_rope<64>(nc, R64 + t_ * 32, part); } while (0)
        MLA_LOAD(c.gw < S * 2 ? c.gw : 0);
        for (int it = c.gw; it < S * 2; it += c.ngw) { const int t = it >> 1, h = (it & 1) * 8 + hl;
            const H8R<192> aq = nq, ak = nk; const H8C ac = nc;
            { const int itn = it + c.ngw < S * 2 ? it + c.ngw : it; MLA_LOAD(itn); }
            h8_finish<192, 64, true>(aq, Qb + (size_t)t * 3072 + h * 192 + part * 8, Gq, ac, c.lane);
            h8_finish<192, 64, true>(ak, Kb + (size_t)t * 3072 + h * 192 + part * 8, Gk, ac, c.lane); }
#undef MLA_LOAD
    }
    SEAM(6);
    if (IN(7)) { fa::AttnP A{Qb, Kb, KVRAW + 128, Ob, 0.07216878364870322f * fa::LOG2E, nullptr, nullptr, nullptr, 0.f, 0.f, nullptr, nullptr}; fa::attn_phase<0, 192, fa::Strides<3072, 192, 3072, 192, 4096, 256, 0>>(A, c.lds, c.blk, c.G, c.wave); }
    SEAM(7);
    WOUT(0, 8, xin)
    FFN_PHASES(0, 9)

    WIN(11, WS_W_DSA_IN, N_DSA_IN, BO_DSA, P, 0)
    if (IN(12)) {
        const float* gq = (const float*)a.in[I_DSA_QG]; const float* gk = (const float*)a.in[I_DSA_KG]; const float* gik = (const float*)a.in[I_DSA_IKG];
        const int hl = c.lane >> 3, part = c.lane & 7;
        H8G<128> Gq, Gk; h8_gain<128>(Gq, gq, part); h8_gain<128>(Gk, gk, part); const H8G<64> G0{}; H8G<64> Gik; h8_gain<64>(Gik, gik, part);
        H8R<128> nq[2], nk[2]; H8R<64> ni[2], nik; H8C nc32, nc16; unsigned nw;
#define DSA_LOAD(T) do { const bf16* row_ = P + (size_t)(T) * N_DSA_IN; _Pragma("unroll") for (int hb = 0; hb < 2; ++hb) { const bf16* q_ = row_ + (hb * 8 + hl) * 128 + part * 8; \
            h8_load<128>(nq[hb], q_, q_ + 64); h8_load<128>(nk[hb], q_ + 2048, q_ + 2048 + 64); h8_load<64>(ni[hb], row_ + 6144 + (hb * 8 + hl) * 64 + part * 8, nullptr); } \
            h8_load<64>(nik, row_ + 7168 + part * 8, nullptr); nw = ((const unsigned short*)row_)[7232 + (c.lane & 15)]; \
            h8_rope<32>(nc32, R32 + (T) * 16, part); h8_rope<16>(nc16, R16 + (T) * 8, part); } while (0)
        DSA_LOAD(c.gw < S ? c.gw : 0);
        for (int t = c.gw; t < S; t += c.ngw) { bf16* row = P + (size_t)t * N_DSA_IN;
            H8R<128> aq[2] = {nq[0], nq[1]}, ak[2] = {nk[0], nk[1]}; H8R<64> ai[2] = {ni[0], ni[1]}; const H8R<64> aik = nik; const unsigned aw = nw; const H8C ac32 = nc32, ac16 = nc16;
            { const int tn = t + c.ngw < S ? t + c.ngw : t; DSA_LOAD(tn); }
#pragma unroll
            for (int hb = 0; hb < 2; ++hb) { bf16* q = row + (hb * 8 + hl) * 128 + part * 8; bf16* k = q + 2048; bf16* iq = row + 6144 + (hb * 8 + hl) * 64 + part * 8;
                h8_finish<128, 32, true>(aq[hb], q, Gq, ac32, c.lane);
                h8_finish<128, 32, true>(ak[hb], k, Gk, ac32, c.lane);
                h8_finish<64, 16, false>(ai[hb], iq, G0, ac16, c.lane); }
            h8_finish<64, 16, true>(aik, c.lane < 8 ? row + 7168 + part * 8 : (bf16*)(ws + WS_O1) + c.lane * 8, Gik, ac16, c.lane);
            if (c.lane < 16) IW[t * 16 + c.lane] = bf2f(aw) * 0.25f; }
#undef DSA_LOAD
    }
    SEAM(12);
    if (IN(13)) score_mfma(P, IW, SIDX, c);
    SEAM(13);
    if (IN(14)) select_phase(SIDX, MASK, c);
    SEAM(14);
    if (IN(15)) { fa::AttnP A{P, P + 2048, P + 4096, Ob, 0.08838834764831845f * fa::LOG2E, MASK, nullptr, nullptr, 0.f, 0.f, nullptr, nullptr}; fa::attn_phase<1, 128, fa::Strides<N_DSA_IN, 128, N_DSA_IN, 128, N_DSA_IN, 128, 0>>(A, c.lds, c.blk, c.G, c.wave); }
    SEAM(15);
    WOUT(1, 16, out)
    FFN_PHASES(1, 17)

    WIN(19, WS_W_DIFF_IN, N_DIFF_IN, BO_DIFF, P, 0)
    if (IN(20)) {
        const float* gq = (const float*)a.in[I_DIFF_QG]; const float* gk = (const float*)a.in[I_DIFF_KG];
        const int hl = c.lane >> 3, part = c.lane & 7;
        H8G<64> Gq, Gk; h8_gain<64>(Gq, gq, part); h8_gain<64>(Gk, gk, part);
        H8R<64> nq[4], nk[4]; H8C nc;
#define DIFF_LOAD(T) do { const bf16* row_ = P + (size_t)(T) * N_DIFF_IN; _Pragma("unroll") for (int hb = 0; hb < 4; ++hb) { const bf16* q_ = row_ + (hb * 8 + hl) * 64 + part * 8; \
            h8_load<64>(nq[hb], q_, nullptr); h8_load<64>(nk[hb], q_ + 2048, nullptr); } h8_rope<16>(nc, R16 + (T) * 8, part); } while (0)
        DIFF_LOAD(c.gw < S ? c.gw : 0);
        for (int t = c.gw; t < S; t += c.ngw) { bf16* row = P + (size_t)t * N_DIFF_IN;
            H8R<64> aq[4] = {nq[0], nq[1], nq[2], nq[3]}, ak[4] = {nk[0], nk[1], nk[2], nk[3]}; const H8C ac = nc;
            { const int tn = t + c.ngw < S ? t + c.ngw : t; DIFF_LOAD(tn); }
#pragma unroll
            for (int hb = 0; hb < 4; ++hb) { bf16* q = row + (hb * 8 + hl) * 64 + part * 8; bf16* k = q + 2048;
                h8_finish<64, 16, true>(aq[hb], q, Gq, ac, c.lane);
                h8_finish<64, 16, true>(ak[hb], k, Gk, ac, c.lane); } }
#undef DIFF_LOAD
    }
    SEAM(20);
    if (IN(21)) {
        const float* lq1 = (const float*)a.in[I_DIFF_LQ1]; const float* lk1 = (const float*)a.in[I_DIFF_LK1];
        const float* lq2 = (const float*)a.in[I_DIFF_LQ2]; const float* lk2 = (const float*)a.in[I_DIFF_LK2];
        float d1 = 0.f, d2 = 0.f;
        for (int i = 0; i < 64; ++i) { d1 += lq1[i] * lk1[i]; d2 += lq2[i] * lk2[i]; }
        const float lam_init = 0.8f - 0.6f * 0.5488116360940264f;
        const float lam = __expf(d1) - __expf(d2) + lam_init;
        fa::AttnP A{P, P + 2048, P + 4096, Ob, 0.125f * fa::LOG2E, nullptr, nullptr, nullptr, lam, 1.f - lam_init, (const float*)a.in[I_DIFF_SUBG], (float*)(ws + WS_O1)};
        fa::attn_phase<2, 64, fa::Strides<N_DIFF_IN, 64, N_DIFF_IN, 64, N_DIFF_IN, 128, 0>>(A, c.lds, c.blk, c.G, c.wave);
    }
    SEAM(21);
    WOUT(2, 22, out)
    FFN_PHASES(2, 23)

    WIN(25, WS_W_FOX_IN, N_FOX_IN, BO_FOX, P, 1)
    if (IN(26)) {
        const float* gq = (const float*)a.in[I_FOX_QG]; const float* gk = (const float*)a.in[I_FOX_KG]; const float* bfv = (const float*)a.in[I_FOX_BF];
        const int hl = c.lane >> 3, part = c.lane & 7;
        H8G<128> Gq, Gk; h8_gain<128>(Gq, gq, part); h8_gain<128>(Gk, gk, part); const H8C C0{};
        H8R<128> nq[2], nk[2]; unsigned nz;
#define FOX_LOAD(T) do { const bf16* row_ = P + (size_t)(T) * N_FOX_IN; _Pragma("unroll") for (int hb = 0; hb < 2; ++hb) { const bf16* q_ = row_ + (hb * 8 + hl) * 128 + part * 8; \
            h8_load<128>(nq[hb], q_, q_ + 64); h8_load<128>(nk[hb], q_ + 2048, q_ + 2048 + 64); } nz = ((const unsigned short*)row_)[8192 + (c.lane & 15)]; } while (0)
        FOX_LOAD(c.gw < S ? c.gw : 0);
        for (int t = c.gw; t < S; t += c.ngw) { bf16* row = P + (size_t)t * N_FOX_IN;
            H8R<128> aq[2] = {nq[0], nq[1]}, ak[2] = {nk[0], nk[1]}; const unsigned az = nz;
            { const int tn = t + c.ngw < S ? t + c.ngw : t; FOX_LOAD(tn); }
#pragma unroll
            for (int hb = 0; hb < 2; ++hb) { bf16* q = row + (hb * 8 + hl) * 128 + part * 8; bf16* k = q + 2048;
                h8_finish<128, 0, true>(aq[hb], q, Gq, C0, c.lane);
                h8_finish<128, 0, true>(ak[hb], k, Gk, C0, c.lane); }
            if (c.lane < 16) { const float z = bf2f(az) + bfv[c.lane];
                LOGF[(size_t)c.lane * S + t] = z >= 0.f ? -log1pf(__expf(-z)) : z - log1pf(__expf(z)); } }
#undef FOX_LOAD
    }
    SEAM(26);
    if (IN(27)) ph_cumsum(LOGF, (float*)(ws + WS_CUM), c);
    SEAM(27);
    if (IN(28)) { fa::AttnP A{P, P + 2048, P + 4096, Ob, 0.08838834764831845f * fa::LOG2E, nullptr, (const float*)(ws + WS_CUM), P + 6144, 0.f, 0.f, nullptr, nullptr}; fa::attn_phase<3, 128, fa::Strides<N_FOX_IN, 128, N_FOX_IN, 128, N_FOX_IN, 128, N_FOX_IN>>(A, c.lds, c.blk, c.G, c.wave); }
    SEAM(28);
    WOUT(3, 29, out)
    FFN_PHASES(3, 30)
#undef IN
#undef SEAM
#undef mod
#undef XB
#undef P
#undef Ob
#undef HID
#undef STAT
#undef BIAS
#undef BIASP
#undef xin
#undef out
#undef R64
#undef R32
#undef R16
#undef PM
#undef CN
#undef QRAW
#undef KVRAW
#undef Qb
#undef Kb
#undef IW
#undef SIDX
#undef MASK
#undef LOGF
}

extern "C" void kernel_launch(void* const* d_in, const int* in_sizes, int n_in, void* d_out, int out_size, void* d_ws, size_t ws_size, hipStream_t stream) {
    static int grid = 0;
    if (grid == 0) {
        if (n_in != N_IN || out_size != S * D || ws_size < WS_END) { fprintf(stderr, "kernel_launch: unexpected shapes: n_in %d out %d ws %zu (need %zu)\n", n_in, out_size, ws_size, (size_t)WS_END); grid = -1; return; }
        int dev = 0, cus = 0;
        if (hipGetDevice(&dev) != hipSuccess || hipDeviceGetAttribute(&cus, hipDeviceAttributeMultiprocessorCount, dev) != hipSuccess) { grid = -1; return; }
        if (hipFuncSetAttribute((const void*)mega, hipFuncAttributeMaxDynamicSharedMemorySize, LDS_BYTES) != hipSuccess) { fprintf(stderr, "kernel_launch: hipFuncSetAttribute failed\n"); grid = -1; return; }
        int per_cu = 0;
        if (hipOccupancyMaxActiveBlocksPerMultiprocessor(&per_cu, (const void*)mega, 512, LDS_BYTES) != hipSuccess || per_cu < 1) fprintf(stderr, "kernel_launch: occupancy query says %d\n", per_cu);
        (void)hipGetLastError();
        grid = cus;
    }
    if (grid < 0) return;
    (void)hipMemsetAsync((char*)d_ws + WS_CTL, 0, CTL_ZERO_BYTES, stream);
    Args a{};
    for (int i = 0; i < N_IN; ++i) a.in[i] = d_in[i];
    a.out = (float*)d_out; a.ws = (unsigned char*)d_ws;
#if MK_PER_PHASE
    for (int p = 0; p < NPHASE; ++p) { a.ph_lo = p; a.ph_hi = p + 1; hipLaunchKernelGGL(mega, dim3(grid), dim3(512), LDS_BYTES, stream, a); }
#else
    a.ph_lo = 0; a.ph_hi = NPHASE; hipLaunchKernelGGL(mega, dim3(grid), dim3(512), LDS_BYTES, stream, a);
#endif
}
```

```cpp
#include <hip/hip_runtime.h>
#include <cstdio>
#include <cstdint>

#ifndef REP_MASK
#define REP_MASK 0
#endif
#define LAS __attribute__((address_space(3)))
typedef unsigned short bf16;
typedef short bf16x8 __attribute__((ext_vector_type(8)));
typedef float f32x4 __attribute__((ext_vector_type(4)));
typedef float f32x2 __attribute__((ext_vector_type(2)));
typedef float f32x16 __attribute__((ext_vector_type(16)));
typedef unsigned u32x4 __attribute__((ext_vector_type(4)));
typedef unsigned u32x2 __attribute__((ext_vector_type(2)));
typedef unsigned long long u64;

constexpr int S = 8192, D = 2048, NH = 16, FF = 5632, NMOD = 6 * D;
constexpr float EPS = 1e-6f;
constexpr int N_MLA_IN = 1280, N_DSA_IN = 7424, N_DIFF_IN = 6144, N_FOX_IN = 8448;
enum { I_X = 0, I_C, I_POS, I_LN_MIX, I_LN_FFN, I_ADA_W, I_ADA_B, I_FFN_GU, I_FFN_DN,
       I_MLA_IN, I_MLA_QAG, I_MLA_KVAG, I_MLA_QB, I_MLA_KVB, I_MLA_QG, I_MLA_KG, I_MLA_OUT,
       I_DSA_IN, I_DSA_QG, I_DSA_KG, I_DSA_IKG, I_DSA_OUT,
       I_DIFF_IN, I_DIFF_QG, I_DIFF_KG, I_DIFF_LQ1, I_DIFF_LK1, I_DIFF_LQ2, I_DIFF_LK2, I_DIFF_SUBG, I_DIFF_OUT,
       I_FOX_IN, I_FOX_BF, I_FOX_QG, I_FOX_KG, I_FOX_OUT, N_IN };

constexpr size_t MiB = 1u << 20;
constexpr size_t WS_CTL = 0;
constexpr size_t WS_MODP = 1 * MiB;
constexpr size_t WS_MOD = 3 * MiB;
constexpr size_t WS_ROPE64 = 4 * MiB;
constexpr size_t WS_ROPE32 = 6 * MiB;
constexpr size_t WS_ROPE16 = 7 * MiB;
constexpr size_t WS_IW = 8 * MiB;
constexpr size_t WS_LOGF = 9 * MiB;
constexpr size_t WS_CUM = 10 * MiB;
constexpr size_t WS_W_MLA_IN = 16 * MiB;
constexpr size_t WS_W_MLA_QB = 21 * MiB;
constexpr size_t WS_W_MLA_KVB = 24 * MiB;
constexpr size_t WS_W_DSA_IN = 28 * MiB;
constexpr size_t WS_W_DIFF_IN = 57 * MiB;
constexpr size_t WS_W_FOX_IN = 81 * MiB;
constexpr size_t WS_W_OUT = 114 * MiB;
constexpr size_t WS_W_GU = 146 * MiB;
constexpr size_t WS_W_DN = 322 * MiB;
constexpr size_t WS_XB = 410 * MiB;
constexpr size_t WS_P = 442 * MiB;
constexpr size_t WS_PM = 574 * MiB;
constexpr size_t WS_CN = 594 * MiB;
constexpr size_t WS_Q = 610 * MiB;
constexpr size_t WS_K = 658 * MiB;
constexpr size_t WS_O = 706 * MiB;
constexpr size_t WS_HID = 738 * MiB;
constexpr size_t WS_MASK = 826 * MiB;
constexpr size_t WS_SIDX = 834 * MiB;
constexpr size_t WS_O1 = 1090 * MiB;
constexpr size_t WS_STAT = 11 * MiB;
constexpr size_t WS_GG = 12 * MiB;
constexpr size_t WS_BIAS = 13 * MiB;
constexpr size_t WS_BIASP = 1154 * MiB;
constexpr size_t WS_XL = 1170 * MiB;
constexpr size_t WS_END = 1202 * MiB;
constexpr size_t CTL_ZERO_BYTES = 1 * MiB;
constexpr int CW_BAR = 4096;

constexpr int LDS_BYTES = 147456;
constexpr int MISC_OFF = LDS_BYTES - 128;

__device__ __forceinline__ unsigned f2bf(float f) { unsigned u = __builtin_bit_cast(unsigned, f); return (u + 0x7fffu + ((u >> 16) & 1u)) >> 16; }
__device__ __forceinline__ unsigned pk2(float lo, float hi) { return f2bf(lo) | (f2bf(hi) << 16); }
__device__ __forceinline__ float bf2f(unsigned b) { return __builtin_bit_cast(float, b << 16); }
__device__ __forceinline__ float wave_sum(float v) {
#pragma unroll
    for (int o = 32; o >= 1; o >>= 1) v += __shfl_xor(v, o);
    return v;
}
__device__ __forceinline__ float wave_max(float v) {
#pragma unroll
    for (int o = 32; o >= 1; o >>= 1) v = fmaxf(v, __shfl_xor(v, o));
    return v;
}

#define XB_TMO      128
#define XB_XCNT(j)  (256  + 64 * (j))
#define XB_XSUB(j)  (1280 + 64 * (j))
#define XB_XGEN(j)  (2304 + 64 * (j))
#define XB_TOP      3328
#define XB_TOPGEN   3392
#define XCD_BAR_WORDS 3456
#define XB_SPIN_CAP (1u << 22)
__device__ __forceinline__ unsigned xb_ld(unsigned* p)              { return __hip_atomic_load(p, __ATOMIC_RELAXED, __HIP_MEMORY_SCOPE_AGENT); }
__device__ __forceinline__ unsigned xb_add(unsigned* p, unsigned v) { return __hip_atomic_fetch_add(p, v, __ATOMIC_RELAXED, __HIP_MEMORY_SCOPE_AGENT); }
__device__ __forceinline__ unsigned xb_xcc_id() { return (unsigned)__builtin_amdgcn_s_getreg((3 << 11) | 20) & 0xFu; }
#define XB_SPIN(cond, bar) do { unsigned _sp = 0; while (cond) { __builtin_amdgcn_s_sleep(1); \
    if ((++_sp & 255u) == 0u) { if (xb_ld(&(bar)[XB_TMO])) break; if (_sp > XB_SPIN_CAP) { atomicAdd(&(bar)[XB_TMO], 1u); break; } } } } while (0)
__device__ __forceinline__ int tid_of(int wave) { int l; asm volatile("v_mbcnt_lo_u32_b32 %0, -1, 0\n\tv_mbcnt_hi_u32_b32 %0, -1, %0" : "=v"(l)); return wave * 64 + l; }
struct XcdBarrier { unsigned* bar; unsigned x; volatile LAS unsigned* st; int wave; };
__device__ __forceinline__ XcdBarrier xcd_barrier_post(unsigned* bar, volatile LAS unsigned* st, int wave) {
    XcdBarrier b; b.bar = bar; b.x = xb_xcc_id(); b.st = st; b.wave = wave;
    if (tid_of(wave) == 0) (void)xb_add(&bar[XB_XCNT(b.x)], 1u);
    return b;
}
__device__ __forceinline__ void xcd_barrier_complete(unsigned* bar, unsigned x, unsigned& nloc, unsigned& nx) {
    const unsigned G = gridDim.x * gridDim.y * gridDim.z;
    unsigned sum, cnt, mine, sp = 0u;
    for (;;) {
        sum = 0u; cnt = 0u; mine = 0u;
#pragma unroll
        for (unsigned j = 0; j < 16; ++j) { const unsigned c = xb_ld(&bar[XB_XCNT(j)]); sum += c; cnt += (c > 0u) ? 1u : 0u; mine = (j == x) ? c : mine; }
        if (sum == G) break;
        __builtin_amdgcn_s_sleep(1);
        if ((++sp & 255u) == 0u) { if (xb_ld(&bar[XB_TMO])) break; if (sp > XB_SPIN_CAP) { atomicAdd(&bar[XB_TMO], 1u); break; } }
    }
    nloc = mine > 0u ? mine : 1u; nx = cnt > 0u ? cnt : 1u;
}
__device__ __forceinline__ void xcd_barrier(const XcdBarrier& b) {
    asm volatile("s_waitcnt vmcnt(0)" ::: "memory");
    __syncthreads();
    if (tid_of(b.wave) == 0) {
        unsigned* bar = b.bar;
        __builtin_amdgcn_s_waitcnt(0);
        unsigned nloc = b.st[0], nx = b.st[1];
        if (nloc == 0u) { xcd_barrier_complete(bar, b.x, nloc, nx); b.st[0] = nloc; b.st[1] = nx; }
        const unsigned old = xb_add(&bar[XB_XSUB(b.x)], 1u);
        const unsigned gen = old / nloc;
        if (old + 1u == (gen + 1u) * nloc) {
            __builtin_amdgcn_fence(__ATOMIC_RELEASE, "agent");
            asm volatile("s_waitcnt vmcnt(0)" ::: "memory");
            const unsigned og = xb_add(&bar[XB_TOP], 1u);
            const unsigned tg = og / nx;
            if (og + 1u == (tg + 1u) * nx) xb_add(&bar[XB_TOPGEN], 1u);
            else XB_SPIN(xb_ld(&bar[XB_TOPGEN]) == tg, bar);
            __builtin_amdgcn_fence(__ATOMIC_ACQUIRE, "agent");
            xb_add(&bar[XB_XGEN(b.x)], 1u);
            asm volatile("s_waitcnt vmcnt(0)" ::: "memory");
        } else {
            XB_SPIN(xb_ld(&bar[XB_XGEN(b.x)]) == gen, bar);
            __builtin_amdgcn_fence(__ATOMIC_ACQUIRE, "agent");
            asm volatile("s_waitcnt vmcnt(0)" ::: "memory");
        }
    }
    __syncthreads();
}

struct Args { const void* in[N_IN]; float* out; unsigned char* ws; int ph_lo, ph_hi; };

struct Ctx { LAS unsigned char* lds; int tid, lane, wave, gw, ngw, G, blk; };
#define GAS __attribute__((address_space(1)))
__device__ __forceinline__ unsigned char* launder_ptr(unsigned char* p) { GAS unsigned char* g = (GAS unsigned char*)p; asm volatile("" : "+s"(g)); return (unsigned char*)g; }
__device__ __forceinline__ void fresh(Ctx& c) { int l; asm volatile("v_mbcnt_lo_u32_b32 %0, -1, 0\n\tv_mbcnt_hi_u32_b32 %0, -1, %0" : "=v"(l)); c.lane = l; c.tid = c.wave * 64 + l; }


constexpr int BO_MLA = 0, BO_DSA = BO_MLA + N_MLA_IN, BO_DIFF = BO_DSA + N_DSA_IN, BO_FOX = BO_DIFF + N_DIFF_IN, BO_GU = BO_FOX + N_FOX_IN, NBIAS = BO_GU + 4 * 2 * FF;
static_assert(NBIAS == 68352, "bias columns");

__device__ __forceinline__ int srccol(int kind, int n, int nsrc) {
    if (kind == 0) return n < nsrc ? n : -1;
    if (kind == 1) { const int t = n >> 8, w = n & 255; return w < 128 ? t * 128 + w : FF + t * 128 + (w - 128); }
    if (n < 6144) return n; if (n < 8192) return n + 16; if (n < 8208) return 6144 + (n - 8192); return -1;
}
__device__ __forceinline__ void transpose_item(const float* W, int K, int nsrc, bf16* WT, int kind, int k0, int n0, const float* gg, const float* sh, float* biasp, int lane) {
    const int n4 = lane & 7, kb = lane >> 3, n = n0 + 4 * n4, col = srccol(kind, n, nsrc);
    f32x4 v[8];
    const float* src = W + (size_t)(k0 + 8 * kb) * nsrc + (col >= 0 ? col : 0);
#pragma unroll
    for (int i = 0; i < 8; ++i) v[i] = *(const f32x4*)(src + (size_t)i * nsrc);
    const float msk = col >= 0 ? 1.f : 0.f;
    float sc[8];
#pragma unroll
    for (int i = 0; i < 8; ++i) sc[i] = msk;
    if (gg) { const f32x4 g0 = *(const f32x4*)(gg + k0 + 8 * kb), g1 = *(const f32x4*)(gg + k0 + 8 * kb + 4), s0 = *(const f32x4*)(sh + k0 + 8 * kb), s1 = *(const f32x4*)(sh + k0 + 8 * kb + 4);
        float b[4];
#pragma unroll
        for (int j = 0; j < 4; ++j) { b[j] = (s0[0] * v[0][j] + s0[1] * v[1][j] + s0[2] * v[2][j] + s0[3] * v[3][j] + s1[0] * v[4][j] + s1[1] * v[5][j] + s1[2] * v[6][j] + s1[3] * v[7][j]) * msk;
            b[j] += __shfl_xor(b[j], 8); b[j] += __shfl_xor(b[j], 16); b[j] += __shfl_xor(b[j], 32); }
        if (kb == 0) *(f32x4*)(biasp + n) = (f32x4){b[0], b[1], b[2], b[3]};
#pragma unroll
        for (int i = 0; i < 4; ++i) { sc[i] *= g0[i]; sc[4 + i] *= g1[i]; } }
    bf16* dst = WT + (size_t)n * K + k0 + 8 * kb;
#pragma unroll
    for (int j = 0; j < 4; ++j) { u32x4 o; o.x = pk2(v[0][j] * sc[0], v[1][j] * sc[1]); o.y = pk2(v[2][j] * sc[2], v[3][j] * sc[3]); o.z = pk2(v[4][j] * sc[4], v[5][j] * sc[5]); o.w = pk2(v[6][j] * sc[6], v[7][j] * sc[7]);
        *(u32x4*)(dst + (size_t)j * K) = o; }
}
struct WDesc { int in_idx; int layer; int K, nsrc, npad, kind; size_t dst; int norm  , bo; };
__device__ __forceinline__ WDesc wdesc(int m) {
    switch (m) {
    case 0: return {I_MLA_IN, 0, D, 1088, N_MLA_IN, 0, WS_W_MLA_IN, 0, BO_MLA};
    case 1: return {I_MLA_QB, 0, 512, 3072, 3072, 0, WS_W_MLA_QB, -1, 0};
    case 2: return {I_MLA_KVB, 0, 512, 4096, 4096, 0, WS_W_MLA_KVB, -1, 0};
    case 3: return {I_MLA_OUT, 0, D, D, D, 0, WS_W_OUT + 0 * 8 * MiB, -1, 0};
    case 4: return {I_DSA_IN, 0, D, 7248, N_DSA_IN, 0, WS_W_DSA_IN, 1, BO_DSA};
    case 5: return {I_DSA_OUT, 0, D, D, D, 0, WS_W_OUT + 1 * 8 * MiB, -1, 0};
    case 6: return {I_DIFF_IN, 0, D, 6144, N_DIFF_IN, 0, WS_W_DIFF_IN, 2, BO_DIFF};
    case 7: return {I_DIFF_OUT, 0, D, D, D, 0, WS_W_OUT + 2 * 8 * MiB, -1, 0};
    case 8: return {I_FOX_IN, 0, D, 8208, N_FOX_IN, 2, WS_W_FOX_IN, 3, BO_FOX};
    case 9: return {I_FOX_OUT, 0, D, D, D, 0, WS_W_OUT + 3 * 8 * MiB, -1, 0};
    case 10: case 11: case 12: case 13: return {I_FFN_GU, m - 10, D, 2 * FF, 2 * FF, 1, WS_W_GU + (size_t)(m - 10) * 44 * MiB, 4 + (m - 10), BO_GU + (m - 10) * 2 * FF};
    default: return {I_FFN_DN, m - 14, FF, D, D, 0, WS_W_DN + (size_t)(m - 14) * 22 * MiB, -1, 0};
    }
}
__device__ __forceinline__ void ph_phase0(const Args& a, const Ctx& c) {
    LAS float* cond = (LAS float*)c.lds;
    const float* cin = (const float*)a.in[I_C];
    for (int i = c.tid; i < D; i += 512) { const float v = cin[i]; cond[i] = v / (1.f + __expf(-v)); }
    __syncthreads();
    {
        const float* W = (const float*)a.in[I_ADA_W]; float* modp = (float*)(a.ws + WS_MODP);
        for (int task = c.gw; task < 4 * 48 * 8; task += c.ngw) {
            const int ks = task & 7, cg = (task >> 3) % 48, l = task / (8 * 48);
            const float* wp = W + ((size_t)l * D + ks * 256) * NMOD + cg * 256 + c.lane * 4;
            f32x4 acc = {0.f, 0.f, 0.f, 0.f};
#pragma unroll 8
            for (int k = 0; k < 256; ++k) { const f32x4 w = *(const f32x4*)(wp + (size_t)k * NMOD); acc += w * cond[ks * 256 + k]; }
            *(f32x4*)(modp + ((size_t)(ks * 4 + l)) * NMOD + cg * 256 + c.lane * 4) = acc;
        }
    }
    {
        const int* pos = (const int*)a.in[I_POS];
        f32x2* r64 = (f32x2*)(a.ws + WS_ROPE64); f32x2* r32 = (f32x2*)(a.ws + WS_ROPE32); f32x2* r16 = (f32x2*)(a.ws + WS_ROPE16);
        const int gt = c.blk * 512 + c.tid, ngt = c.G * 512;
        for (int i = gt; i < S * 56; i += ngt) {
            const int t = i / 56, j = i % 56; int rot, fi; f32x2* dst;
            if (j < 32) { rot = 64; fi = j; dst = r64 + t * 32 + fi; } else if (j < 48) { rot = 32; fi = j - 32; dst = r32 + t * 16 + fi; } else { rot = 16; fi = j - 48; dst = r16 + t * 8 + fi; }
            const float invf = (float)exp2(-(double)(2 * fi) / (double)rot * 18.931568569324174);
            const float ang = (float)pos[t] * invf;
            double rev = (double)ang * 0.15915494309189535; rev -= rint(rev);
            const float rv = (float)rev;
            *dst = (f32x2){__builtin_amdgcn_cosf(rv), __builtin_amdgcn_sinf(rv)};
        }
    }
    {
        const float* x = (const float*)a.in[I_X]; bf16* xb = (bf16*)(a.ws + WS_XB); bf16* xl = (bf16*)(a.ws + WS_XL); float* stat = (float*)(a.ws + WS_STAT);
        f32x4 nx[8];
        { const f32x4* xr = (const f32x4*)(x + (size_t)(c.gw < S ? c.gw : 0) * D) + c.lane;
#pragma unroll
          for (int j = 0; j < 8; ++j) nx[j] = xr[64 * j]; }
        for (int r = c.gw; r < S; r += c.ngw) {
            u32x2* o = (u32x2*)(xb + (size_t)r * D) + c.lane; u32x2* ol = (u32x2*)(xl + (size_t)r * D) + c.lane; float ss = 0.f;
            f32x4 cx[8];
#pragma unroll
            for (int j = 0; j < 8; ++j) cx[j] = nx[j];
            { const int rn = r + c.ngw < S ? r + c.ngw : r; const f32x4* xr = (const f32x4*)(x + (size_t)rn * D) + c.lane;
#pragma unroll
              for (int j = 0; j < 8; ++j) nx[j] = xr[64 * j]; }
#pragma unroll
            for (int j = 0; j < 8; ++j) { const f32x4 v = cx[j]; ss += v.x * v.x + v.y * v.y + v.z * v.z + v.w * v.w; const unsigned h0 = pk2(v.x, v.y), h1 = pk2(v.z, v.w);
                o[64 * j] = (u32x2){h0, h1}; ol[64 * j] = (u32x2){pk2(v.x - bf2f(h0 & 0xffffu), v.y - bf2f(h0 >> 16)), pk2(v.z - bf2f(h1 & 0xffffu), v.w - bf2f(h1 >> 16))}; }
            ss = wave_sum(ss);
            if (c.lane < 8) stat[r * 8 + c.lane] = c.lane == 0 ? ss : 0.f;
        }
    }
}
__device__ __forceinline__ void ph_modfinal(const Args& a, const Ctx& c) {
    const float* modp = (const float*)(a.ws + WS_MODP); const float* b = (const float*)a.in[I_ADA_B]; float* mod = (float*)(a.ws + WS_MOD); float* gg = (float*)(a.ws + WS_GG);
    for (int i = c.blk * 512 + c.tid; i < 4 * NMOD; i += c.G * 512) {
        const int l = i / NMOD, col = i % NMOD; float s = b[i];
#pragma unroll
        for (int ks = 0; ks < 8; ++ks) s += modp[(size_t)(ks * 4 + l) * NMOD + col];
        mod[i] = s;
        const int seg = col / D, k = col % D;
        if (seg == 1) gg[l * D + k] = ((const float*)a.in[I_LN_MIX])[l * D + k] * (1.f + s);
        if (seg == 4) gg[(4 + l) * D + k] = ((const float*)a.in[I_LN_FFN])[l * D + k] * (1.f + s);
    }
}
__device__ __forceinline__ void ph_weights(const Args& a, const Ctx& c) {
    const float* mod = (const float*)(a.ws + WS_MOD); const float* gga = (const float*)(a.ws + WS_GG); float* biasp = (float*)(a.ws + WS_BIASP);
    for (int m = 0; m < 18; ++m) {
        const WDesc d = wdesc(m);
        const float* W = (const float*)a.in[d.in_idx] + (size_t)d.layer * d.K * d.nsrc;
        bf16* WT = (bf16*)(a.ws + d.dst);
        const float* gg = d.norm >= 0 ? gga + d.norm * D : nullptr;
        const float* sh = d.norm >= 0 ? mod + (d.norm & 3) * NMOD + (d.norm >= 4 ? 3 * D : 0) : nullptr;
        const int nblk = d.npad / 32, nitems = (d.K / 64) * nblk;
        for (int it = c.gw; it < nitems; it += c.ngw) { const int kt = it / nblk, n0 = 32 * (it % nblk);
            transpose_item(W, d.K, d.nsrc, WT, d.kind, 64 * kt, n0, gg, sh, biasp + (size_t)kt * NBIAS + d.bo, c.lane); }
    }
}
namespace pg8 {
constexpr int BM = 256, BK = 64, HALF = 128, HTB = HALF * BK * 2, STAGE_BYTES = 8 * HTB, NXCD = 8, WGM = 8;
__host__ __device__ __forceinline__ int lds_byte(int r, int c) { const int st = (r >> 4) * 2 + (c >> 5), rr = r & 15, cc = c & 31, ob = rr * 64 + cc * 2; return st * 1024 + (ob ^ (((ob >> 9) & 1) << 5)); }
__host__ __device__ __forceinline__ void stage_rc(int b, int& R, int& C) { const int st = b / 1024, sb = b % 1024, swz = sb ^ (((sb >> 9) & 1) << 5); R = (st >> 1) * 16 + swz / 64; C = (st & 1) * 32 + (swz % 64) / 2; }
__host__ __device__ __forceinline__ int perm32(int rho) { const int n = rho >> 4, i = rho & 15; return 8 * (i >> 2) + 4 * n + (i & 3); }
struct Unit { int pm, pn, hsel; };
struct Gemm { const bf16* A; int lda; const bf16* Bt; int ldb; int M, N, K; };
struct StaticOrder {
    int nM, nN, nwg, G, c, nhalf;
    __device__ void init(int M, int N, int G_, int c_, int nht = 0) { nM = M / BM; nN = N / BM - nht; nwg = nM * nN; G = G_; c = c_; nhalf = 2 * nM * nht; }
    __device__ bool next(int i, Unit& u) const {
        const long L = (long)i * G + c; if (L >= nwg + nhalf) return false;
        const bool isH = L >= nwg; const int h = (int)L - nwg;
        int wgid = isH ? 0 : (int)L; { const int q = nwg / NXCD, r = nwg % NXCD, xcd = wgid % NXCD, off = wgid / NXCD; wgid = (xcd < r ? xcd * (q + 1) : r * (q + 1) + (xcd - r) * q) + off; }
        const int nig = WGM * nN, gid = wgid / nig, fm = gid * WGM, gsz = (nM - fm) < WGM ? (nM - fm) : WGM;
        const int fpm = fm + ((wgid % nig) % gsz), fpn = (wgid % nig) / gsz;
        u.pm = isH ? (h >> 1) % nM : fpm; u.pn = isH ? nN + (h >> 1) / nM : fpn; u.hsel = isH ? (h & 1) : -1; return true;
    }
};
__device__ __forceinline__ unsigned cvt_pk_bf16(float lo, float hi) { unsigned r; asm volatile("v_cvt_pk_bf16_f32 %0, %1, %2" : "=v"(r) : "v"(lo), "v"(hi)); return r; }
__device__ __forceinline__ float row_rstd(const float* stat, int row) { const f32x4 a = *(const f32x4*)(stat + row * 8), b = *(const f32x4*)(stat + row * 8 + 4);
    return rsqrtf(((a.x + a.y) + (a.z + a.w) + (b.x + b.y) + (b.z + b.w)) * (1.f / D) + EPS); }
struct EpiStoreP { bf16* O; int ldc; const float* stat; const float* bias;
    __device__ __forceinline__ void operator()(const f32x4 (&acc)[2][2][4][2], const Unit& u, int wr, int wc, int fr, int fq, LAS unsigned char*) const {
        const int row0 = u.pm * BM + (u.hsel > 0 ? HALF : 0) + wr * 64 + fr, col0 = u.pn * BM + wc * 32 + 8 * fq; const int nai = u.hsel >= 0 ? 1 : 2;
        f32x4 bv[2][2];
#pragma unroll
        for (int bj = 0; bj < 2; ++bj)
#pragma unroll
            for (int n = 0; n < 2; ++n) bv[bj][n] = stat ? *(const f32x4*)(bias + col0 + bj * HALF + 4 * n) : (f32x4){0.f, 0.f, 0.f, 0.f};
        float rsv[2][4];
#pragma unroll
        for (int ai = 0; ai < 2; ++ai) if (ai < nai)
#pragma unroll
            for (int m = 0; m < 4; ++m) rsv[ai][m] = stat ? row_rstd(stat, row0 + ai * HALF + m * 16) : 1.f;
#pragma unroll
        for (int ai = 0; ai < 2; ++ai) if (ai < nai)
#pragma unroll
            for (int m = 0; m < 4; ++m) { const int row = row0 + ai * HALF + m * 16; bf16* rowp = O + (size_t)row * ldc + col0;
                const float rs = rsv[ai][m];
#pragma unroll
                for (int bj = 0; bj < 2; ++bj) { const f32x4 v0 = acc[ai][bj][m][0] * rs + bv[bj][0], v1 = acc[ai][bj][m][1] * rs + bv[bj][1];
                    u32x4 w; w.x = cvt_pk_bf16(v0[0], v0[1]); w.y = cvt_pk_bf16(v0[2], v0[3]); w.z = cvt_pk_bf16(v1[0], v1[1]); w.w = cvt_pk_bf16(v1[2], v1[3]);
                    *(u32x4*)(rowp + bj * HALF) = w; } }
    } };
template <bool LAST>
struct EpiResP { bf16* xb; bf16* xl; const float* g; float* stat; float* fout;
    __device__ __forceinline__ void operator()(const f32x4 (&acc)[2][2][4][2], const Unit& u, int wr, int wc, int fr, int fq, LAS unsigned char* lds) const {
        const int col0 = u.pn * BM + wc * 32 + 8 * fq;
        LAS float* part = (LAS float*)(lds + 132096);
        f32x4 gv[2][2];
#pragma unroll
        for (int bj = 0; bj < 2; ++bj)
#pragma unroll
            for (int n = 0; n < 2; ++n) gv[bj][n] = *(const f32x4*)(g + col0 + bj * HALF + 4 * n);
#pragma unroll
        for (int ai = 0; ai < 2; ++ai) {
            u32x4 hv[4][2], lv[4][2];
#pragma unroll
            for (int m = 0; m < 4; ++m) { const size_t o = (size_t)(u.pm * BM + wr * 64 + fr + ai * HALF + m * 16) * D + col0;
#pragma unroll
                for (int bj = 0; bj < 2; ++bj) { hv[m][bj] = *(const u32x4*)(xb + o + bj * HALF); lv[m][bj] = *(const u32x4*)(xl + o + bj * HALF); } }
#pragma unroll
            for (int m = 0; m < 4; ++m) { const int rl = wr * 64 + fr + ai * HALF + m * 16; const size_t o = (size_t)(u.pm * BM + rl) * D + col0; float ss = 0.f;
#pragma unroll
                for (int bj = 0; bj < 2; ++bj) { const size_t oo = o + bj * HALF; float xn[8];
#pragma unroll
                    for (int e = 0; e < 4; ++e) { const unsigned hw = hv[m][bj][e], lw = lv[m][bj][e];
                        xn[2 * e] = (bf2f(hw & 0xffffu) + bf2f(lw & 0xffffu)) + gv[bj][e >> 1][(2 * e) & 3] * acc[ai][bj][m][e >> 1][(2 * e) & 3];
                        xn[2 * e + 1] = (bf2f(hw >> 16) + bf2f(lw >> 16)) + gv[bj][e >> 1][(2 * e + 1) & 3] * acc[ai][bj][m][e >> 1][(2 * e + 1) & 3]; }
                    ss += (xn[0] * xn[0] + xn[1] * xn[1]) + (xn[2] * xn[2] + xn[3] * xn[3]) + (xn[4] * xn[4] + xn[5] * xn[5]) + (xn[6] * xn[6] + xn[7] * xn[7]);
                    if constexpr (LAST) { *(f32x4*)(fout + oo) = (f32x4){xn[0], xn[1], xn[2], xn[3]}; *(f32x4*)(fout + oo + 4) = (f32x4){xn[4], xn[5], xn[6], xn[7]}; }
                    else { u32x4 w, wl;
#pragma unroll
                        for (int e = 0; e < 4; ++e) { w[e] = cvt_pk_bf16(xn[2 * e], xn[2 * e + 1]); wl[e] = cvt_pk_bf16(xn[2 * e] - bf2f(w[e] & 0xffffu), xn[2 * e + 1] - bf2f(w[e] >> 16)); }
                        *(u32x4*)(xb + oo) = w; *(u32x4*)(xl + oo) = wl; } }
                ss += __shfl_xor(ss, 16); ss += __shfl_xor(ss, 32);
                if (fq == 0) part[rl * 4 + wc] = ss; } }
        asm volatile("s_waitcnt lgkmcnt(0)" ::: "memory"); __builtin_amdgcn_s_barrier();
        const int tid = (wr * 4 + wc) * 64 + fq * 16 + fr;
        if (tid < 256) { const f32x4 p = *(const LAS f32x4*)(part + tid * 4); stat[(size_t)(u.pm * BM + tid) * 8 + u.pn] = (p.x + p.y) + (p.z + p.w); }
    } };
struct EpiSwigluP { bf16* Hd; const float* stat; const float* bias;
    __device__ __forceinline__ void operator()(const f32x4 (&acc)[2][2][4][2], const Unit& u, int wr, int wc, int fr, int fq, LAS unsigned char*) const {
        const int row0 = u.pm * BM + (u.hsel > 0 ? HALF : 0) + wr * 64 + fr, hc0 = u.pn * HALF + wc * 32 + 8 * fq, col0 = u.pn * BM + wc * 32 + 8 * fq; const int nai = u.hsel >= 0 ? 1 : 2;
        f32x4 bv[2][2];
#pragma unroll
        for (int bj = 0; bj < 2; ++bj)
#pragma unroll
            for (int n = 0; n < 2; ++n) bv[bj][n] = *(const f32x4*)(bias + col0 + bj * HALF + 4 * n);
        float rsv[2][4];
#pragma unroll
        for (int ai = 0; ai < 2; ++ai) if (ai < nai)
#pragma unroll
            for (int m = 0; m < 4; ++m) rsv[ai][m] = row_rstd(stat, row0 + ai * HALF + m * 16);
#pragma unroll
        for (int ai = 0; ai < 2; ++ai) if (ai < nai)
#pragma unroll
            for (int m = 0; m < 4; ++m) { const int row = row0 + ai * HALF + m * 16; const float rs = rsv[ai][m]; float r[8];
#pragma unroll
                for (int n = 0; n < 2; ++n)
#pragma unroll
                    for (int i = 0; i < 4; ++i) { const float gt = acc[ai][0][m][n][i] * rs + bv[0][n][i], up = acc[ai][1][m][n][i] * rs + bv[1][n][i]; r[4 * n + i] = gt * __builtin_amdgcn_rcpf(1.f + __expf(-gt)) * up; }
                u32x4 w; w.x = cvt_pk_bf16(r[0], r[1]); w.y = cvt_pk_bf16(r[2], r[3]); w.z = cvt_pk_bf16(r[4], r[5]); w.w = cvt_pk_bf16(r[6], r[7]);
                *(u32x4*)(Hd + (size_t)row * FF + hc0) = w; }
    } };

template <class Epi>
__device__ __forceinline__ void gemm_phase(LAS unsigned char* lds, const Gemm g, const StaticOrder& S, const Epi& E, const int wave) {
    const int tid = tid_of(wave), wid = wave, lane = tid & 63, wr = wid >> 2, wc = wid & 3, fr = lane & 15, fq = lane >> 4;
    const int K = g.K, nt = K / BK;
    unsigned voffA[2], voffB[2];
#pragma unroll
    for (int i = 0; i < 2; ++i) { int R, C; stage_rc(tid * 16 + i * 8192, R, C); const int Rb = (R & ~31) + perm32(R & 31);
        voffA[i] = (unsigned)(R * g.lda + C) * 2u; voffB[i] = (unsigned)(Rb * g.ldb + C) * 2u; }
    const size_t kstep = (size_t)(BK * 2);
    const size_t hstepA = (size_t)HALF * g.lda * 2, hstepB = (size_t)HALF * g.ldb * 2;
    const size_t tstepA = 2 * hstepA, tstepB = 2 * hstepB;
    const unsigned ldsw = (unsigned)wid * 1024u;
    const int aoff = lds_byte(wr * 64 + fr, fq * 8), boff = lds_byte(wc * 32 + fr, fq * 8);
#define PG8_SA(b, h) (((b) * 2 + (h)) * HTB)
#define PG8_SB(b, h) ((4 + (b) * 2 + (h)) * HTB)
#define PG8_STAGE(bufoff, gbase, voff) do { _Pragma("unroll") for (int _i = 0; _i < 2; ++_i) \
        __builtin_amdgcn_global_load_lds((const unsigned*)((const char*)(gbase) + (voff)[_i]), (LAS unsigned*)(lds + (bufoff) + ldsw + _i * 8192), 16, 0, 0); } while (0)
#define PG8_LDA(dst, b, h) do { _Pragma("unroll") for (int m = 0; m < 4; ++m) _Pragma("unroll") for (int k = 0; k < 2; ++k) dst[m][k] = *(const LAS bf16x8*)(lds + PG8_SA(b, h) + aoff + m * 2048 + k * 1024); } while (0)
#define PG8_LDB(dst, b, h) do { _Pragma("unroll") for (int n = 0; n < 2; ++n) _Pragma("unroll") for (int k = 0; k < 2; ++k) dst[n][k] = *(const LAS bf16x8*)(lds + PG8_SB(b, h) + boff + n * 2048 + k * 1024); } while (0)
#define PG8_MMA(ai, bj, At, Bt) do { __builtin_amdgcn_s_setprio(1); _Pragma("unroll") for (int m = 0; m < 4; ++m) _Pragma("unroll") for (int n = 0; n < 2; ++n) _Pragma("unroll") for (int k = 0; k < 2; ++k) \
        acc[ai][bj][m][n] = __builtin_amdgcn_mfma_f32_16x16x32_bf16(Bt[n][k], At[m][k], acc[ai][bj][m][n], 0, 0, 0); __builtin_amdgcn_s_setprio(0); } while (0)
#define PG8_WAIT_V(n) asm volatile("s_waitcnt vmcnt(" #n ")" ::: "memory")
#define PG8_WAIT_L(n) asm volatile("s_waitcnt lgkmcnt(" #n ")" ::: "memory")
#define PG8_BAR __builtin_amdgcn_s_barrier()
#define PG8_SCHED __builtin_amdgcn_sched_barrier(0)
    Unit cur, nxt; int ui = 0;
    if (!S.next(0, cur)) return;
    f32x4 acc[2][2][4][2];
#pragma unroll
    for (int a = 0; a < 2; ++a)
#pragma unroll
        for (int b = 0; b < 2; ++b)
#pragma unroll
            for (int m = 0; m < 4; ++m)
#pragma unroll
                for (int n = 0; n < 2; ++n) acc[a][b][m][n] = (f32x4){0.f, 0.f, 0.f, 0.f};
    bf16x8 At[4][2], B0[2][2], B1[2][2];
    const char* cA = (const char*)g.A + (size_t)cur.pm * tstepA + (cur.hsel > 0 ? hstepA : 0); const char* cB = (const char*)g.Bt + (size_t)cur.pn * tstepB;
    PG8_STAGE(PG8_SB(0, 0), cB, voffB); PG8_STAGE(PG8_SB(0, 1), cB + hstepB, voffB); PG8_STAGE(PG8_SA(0, 0), cA, voffA); PG8_STAGE(PG8_SA(0, 1), cA + hstepA, voffA);
    if (wr == 1) PG8_BAR;
    PG8_WAIT_V(2); PG8_BAR;
    PG8_STAGE(PG8_SB(1, 0), cB + kstep, voffB); PG8_STAGE(PG8_SA(1, 0), cA + kstep, voffA); PG8_STAGE(PG8_SB(1, 1), cB + hstepB + kstep, voffB);
    PG8_WAIT_V(6); PG8_BAR;
    for (;;) {
        const bool has_next = S.next(ui + 1, nxt);
        const char* nA = has_next ? (const char*)g.A + (size_t)nxt.pm * tstepA + (nxt.hsel > 0 ? hstepA : 0) : cA; const char* nB = has_next ? (const char*)g.Bt + (size_t)nxt.pn * tstepB : cB;
        const bool full = cur.hsel < 0;
        for (int t = 0; t < nt; t += 2) {
            const bool last = (t == nt - 2);
            const char* a1 = cA + (size_t)(t + 1) * kstep;
            const char* a2 = last ? nA : cA + (size_t)(t + 2) * kstep; const char* b2 = last ? nB : cB + (size_t)(t + 2) * kstep;
            const char* a3 = a2 + kstep; const char* b3 = b2 + kstep;
            PG8_LDB(B0, 0, 0); PG8_LDB(B1, 0, 1); PG8_SCHED; PG8_LDA(At, 0, 0); PG8_STAGE(PG8_SA(1, 1), a1 + hstepA, voffA);
            PG8_WAIT_V(8); PG8_WAIT_L(0); PG8_BAR; PG8_MMA(0, 0, At, B0); PG8_MMA(0, 1, At, B1); PG8_BAR; PG8_SCHED;
            PG8_LDA(At, 0, 1); PG8_STAGE(PG8_SB(0, 0), b2, voffB); PG8_STAGE(PG8_SB(0, 1), b2 + hstepB, voffB); PG8_STAGE(PG8_SA(0, 0), a2, voffA);
            PG8_WAIT_V(8); PG8_WAIT_L(0); PG8_BAR; if (full) { PG8_MMA(1, 0, At, B0); PG8_MMA(1, 1, At, B1); } PG8_BAR; PG8_SCHED;
            PG8_LDB(B0, 1, 0); PG8_LDB(B1, 1, 1); PG8_SCHED; PG8_LDA(At, 1, 0); PG8_STAGE(PG8_SA(0, 1), a2 + hstepA, voffA);
            PG8_WAIT_V(8); PG8_WAIT_L(0); PG8_BAR; PG8_MMA(0, 0, At, B0); PG8_MMA(0, 1, At, B1); PG8_BAR; PG8_SCHED;
            PG8_LDA(At, 1, 1); PG8_STAGE(PG8_SB(1, 0), b3, voffB); PG8_STAGE(PG8_SB(1, 1), b3 + hstepB, voffB); PG8_STAGE(PG8_SA(1, 0), a3, voffA);
            PG8_WAIT_V(8); PG8_WAIT_L(0); PG8_BAR; if (full) { PG8_MMA(1, 0, At, B0); PG8_MMA(1, 1, At, B1); } PG8_BAR; PG8_SCHED;
        }
        if (wr == 0) PG8_BAR;
        E(acc, cur, wr, wc, fr, fq, lds);
        if (!has_next) break;
#pragma unroll
        for (int a = 0; a < 2; ++a)
#pragma unroll
            for (int b = 0; b < 2; ++b)
#pragma unroll
                for (int m = 0; m < 4; ++m)
#pragma unroll
                    for (int n = 0; n < 2; ++n) acc[a][b][m][n] = (f32x4){0.f, 0.f, 0.f, 0.f};
        cur = nxt; cA = nA; cB = nB; ++ui;
        if (wr == 1) PG8_BAR;
    }
    PG8_WAIT_V(0);
    PG8_BAR;
#undef PG8_SA
#undef PG8_SB
#undef PG8_STAGE
#undef PG8_LDA
#undef PG8_LDB
#undef PG8_MMA
#undef PG8_WAIT_V
#undef PG8_WAIT_L
#undef PG8_BAR
#undef PG8_SCHED
}
}
__device__ __forceinline__ void bias_reduce(const float* biasp, float* bias, int M, int N, int G, int blk, int wave, int nht) {
    pg8::StaticOrder S_; S_.init(M, N, G, blk, nht); pg8::Unit u;
    const int tid = tid_of(wave);
    for (int i = 0; S_.next(i, u); ++i) if (tid < 256) { const int col = u.pn * 256 + tid; float s = 0.f;
#pragma unroll 8
        for (int kt = 0; kt < 32; ++kt) s += biasp[(size_t)kt * NBIAS + col];
        bias[col] = s; }
    asm volatile("s_waitcnt vmcnt(0)" ::: "memory"); __syncthreads();
}
__device__ __forceinline__ void bias_all(const float* biasp, float* bias, int c0, const Ctx& c) {
    for (int col = c0 + c.blk * 512 + c.tid; col < NBIAS; col += c.G * 512) { float s = 0.f;
#pragma unroll
        for (int kt = 0; kt < 32; ++kt) s += biasp[(size_t)kt * NBIAS + col];
        bias[col] = s; }
}
#define GEMM_SITE(EPI_P, Aptr, LDA, Bptr, LDB, MM, NN, KK, NHT) do { pg8::Gemm g_{Aptr, LDA, Bptr, LDB, MM, NN, KK}; pg8::StaticOrder S_; S_.init(MM, NN, c.G, c.blk, NHT); pg8::gemm_phase(c.lds, g_, S_, EPI_P, c.wave); } while (0)

template <int HD, int ROT, bool NORM>
__device__ __forceinline__ void heads8_norm_rope(const bf16* src0, const bf16* srcn, bf16* dst, const float* gain, const f32x2* rope, int lane) {
    constexpr int V = HD / 64; const int part = lane & 7;
    float x[V][8];
    { const u32x4 r = *(const u32x4*)src0;
#pragma unroll
      for (int e = 0; e < 4; ++e) { x[0][2 * e] = bf2f(r[e] & 0xffffu); x[0][2 * e + 1] = bf2f(r[e] >> 16); } }
#pragma unroll
    for (int v = 1; v < V; ++v) { const u32x4 r = *(const u32x4*)(srcn + 64 * (v - 1));
#pragma unroll
        for (int e = 0; e < 4; ++e) { x[v][2 * e] = bf2f(r[e] & 0xffffu); x[v][2 * e + 1] = bf2f(r[e] >> 16); } }
    if (NORM) { float ss = 0.f;
#pragma unroll
        for (int v = 0; v < V; ++v)
#pragma unroll
            for (int e = 0; e < 8; ++e) ss += x[v][e] * x[v][e];
        ss += __shfl_xor(ss, 1); ss += __shfl_xor(ss, 2); ss += __shfl_xor(ss, 4);
        const float r = rsqrtf(ss * (1.f / HD) + EPS);
#pragma unroll
        for (int v = 0; v < V; ++v) { const f32x4 g0 = *(const f32x4*)(gain + (part + 8 * v) * 8), g1 = *(const f32x4*)(gain + (part + 8 * v) * 8 + 4);
#pragma unroll
            for (int e = 0; e < 4; ++e) { x[v][e] *= r * g0[e]; x[v][4 + e] *= r * g1[e]; } } }
    if (ROT > 0) { constexpr int HL = ROT / 16 > 0 ? ROT / 16 : 1;
        float p[8];
#pragma unroll
        for (int e = 0; e < 8; ++e) p[e] = __shfl_xor(x[0][e], HL);
        if (part < 2 * HL) { const f32x2* rp = rope + (part & (HL - 1)) * 8; const bool lo = part < HL;
#pragma unroll
            for (int e = 0; e < 8; ++e) { const f32x2 cs = rp[e]; x[0][e] = lo ? x[0][e] * cs.x - p[e] * cs.y : x[0][e] * cs.x + p[e] * cs.y; } } }
#pragma unroll
    for (int v = 0; v < V; ++v) { u32x4 w; w.x = pk2(x[v][0], x[v][1]); w.y = pk2(x[v][2], x[v][3]); w.z = pk2(x[v][4], x[v][5]); w.w = pk2(x[v][6], x[v][7]);
        *(u32x4*)(dst + 64 * v) = w; }
}

template <int HD> struct H8R { u32x4 r[HD / 64]; };
template <int HD> struct H8G { f32x4 g[HD / 64][2]; };
struct H8C { f32x2 cs[8]; };
template <int HD> __device__ __forceinline__ void h8_load(H8R<HD>& a, const bf16* src0, const bf16* srcn) {
    a.r[0] = *(const u32x4*)src0;
#pragma unroll
    for (int v = 1; v < HD / 64; ++v) a.r[v] = *(const u32x4*)(srcn + 64 * (v - 1));
}
template <int HD> __device__ __forceinline__ void h8_gain(H8G<HD>& g, const float* gain, int part) {
#pragma unroll
    for (int v = 0; v < HD / 64; ++v) { g.g[v][0] = *(const f32x4*)(gain + (part + 8 * v) * 8); g.g[v][1] = *(const f32x4*)(gain + (part + 8 * v) * 8 + 4); }
}
template <int ROT> __device__ __forceinline__ void h8_rope(H8C& c, const f32x2* rope, int part) {
    constexpr int HL = ROT / 16 > 0 ? ROT / 16 : 1; const f32x2* rp = rope + (part & (HL - 1)) * 8;
#pragma unroll
    for (int e = 0; e < 8; ++e) c.cs[e] = rp[e];
}
template <int HD, int ROT, bool NORM>
__device__ __forceinline__ void h8_finish(const H8R<HD>& a, bf16* dst, const H8G<HD>& G, const H8C& C, int lane) {
    constexpr int V = HD / 64; const int part = lane & 7;
    float x[V][8];
#pragma unroll
    for (int v = 0; v < V; ++v)
#pragma unroll
        for (int e = 0; e < 4; ++e) { x[v][2 * e] = bf2f(a.r[v][e] & 0xffffu); x[v][2 * e + 1] = bf2f(a.r[v][e] >> 16); }
    if (NORM) { float ss = 0.f;
#pragma unroll
        for (int v = 0; v < V; ++v)
#pragma unroll
            for (int e = 0; e < 8; ++e) ss += x[v][e] * x[v][e];
        ss += __shfl_xor(ss, 1); ss += __shfl_xor(ss, 2); ss += __shfl_xor(ss, 4);
        const float r = rsqrtf(ss * (1.f / HD) + EPS);
#pragma unroll
        for (int v = 0; v < V; ++v)
#pragma unroll
            for (int e = 0; e < 4; ++e) { x[v][e] *= r * G.g[v][0][e]; x[v][4 + e] *= r * G.g[v][1][e]; } }
    if (ROT > 0) { constexpr int HL = ROT / 16 > 0 ? ROT / 16 : 1;
        float p[8];
#pragma unroll
        for (int e = 0; e < 8; ++e) p[e] = __shfl_xor(x[0][e], HL);
        if (part < 2 * HL) { const bool lo = part < HL;
#pragma unroll
            for (int e = 0; e < 8; ++e) { const f32x2 cs = C.cs[e]; x[0][e] = lo ? x[0][e] * cs.x - p[e] * cs.y : x[0][e] * cs.x + p[e] * cs.y; } } }
#pragma unroll
    for (int v = 0; v < V; ++v) { u32x4 w; w.x = pk2(x[v][0], x[v][1]); w.y = pk2(x[v][2], x[v][3]); w.z = pk2(x[v][4], x[v][5]); w.w = pk2(x[v][6], x[v][7]);
        *(u32x4*)(dst + 64 * v) = w; }
}

namespace fa {
#define SBAR() __builtin_amdgcn_sched_barrier(0)
typedef short s16x4 __attribute__((ext_vector_type(4)));
constexpr float LOG2E = 1.4426950408889634f;
constexpr float THR2 = 11.5f;
__device__ __forceinline__ int crow(int r, int hi) { return (r & 3) + 8 * (r >> 2) + 4 * hi; }
__device__ __forceinline__ unsigned cvtpk(float lo, float hi) { unsigned r; asm volatile("v_cvt_pk_bf16_f32 %0, %1, %2" : "=v"(r) : "v"(lo), "v"(hi)); return r; }
template <int DQK> __device__ __forceinline__ int kswz(int row, int colB) { return row * (DQK * 2) + (colB ^ ((DQK == 128 ? (row & 15) : ((row >> 1) & 7)) << 4)); }
__device__ __forceinline__ int v_st(int k, int c) { const int kk = (k & ~0xC) | ((k & 4) << 1) | ((k & 8) >> 1); return ((kk >> 3) * 4 + (c >> 5)) * 512 + ((kk & 7) * 32 + (c & 31)) * 2; }
__device__ __forceinline__ int v_rd_base(int lane) { return ((lane & 3) << 3) | (((lane >> 2) & 3) << 6) | (((lane >> 4) & 1) << 5) | (((lane >> 5) & 1) << 8); }
constexpr int v_rd_off(int d0, int ks, int half) { return d0 * 512 + ks * 4096 + half * 2048; }
template <int OFF> __device__ __forceinline__ s16x4 tr_read(int vb) { s16x4 r; asm volatile("ds_read_b64_tr_b16 %0, %1 offset:%2" : "=&v"(r) : "v"(vb), "i"(OFF) : "memory"); return r; }
template <int D0> __device__ __forceinline__ void pv_one(f32x16& od, int vb, bf16x8 pa0, bf16x8 pa1, bf16x8 pa2, bf16x8 pa3) {
    const s16x4 l0 = tr_read<v_rd_off(D0, 0, 0)>(vb), h0 = tr_read<v_rd_off(D0, 0, 1)>(vb), l1 = tr_read<v_rd_off(D0, 1, 0)>(vb), h1 = tr_read<v_rd_off(D0, 1, 1)>(vb);
    const s16x4 l2 = tr_read<v_rd_off(D0, 2, 0)>(vb), h2 = tr_read<v_rd_off(D0, 2, 1)>(vb), l3 = tr_read<v_rd_off(D0, 3, 0)>(vb), h3 = tr_read<v_rd_off(D0, 3, 1)>(vb);
    asm volatile("s_waitcnt lgkmcnt(0)" ::: "memory"); SBAR();
#define PK(L, H) (bf16x8){L[0], L[1], L[2], L[3], H[0], H[1], H[2], H[3]}
    od = __builtin_amdgcn_mfma_f32_32x32x16_bf16(pa0, PK(l0, h0), od, 0, 0, 0);
    od = __builtin_amdgcn_mfma_f32_32x32x16_bf16(pa1, PK(l1, h1), od, 0, 0, 0);
    od = __builtin_amdgcn_mfma_f32_32x32x16_bf16(pa2, PK(l2, h2), od, 0, 0, 0);
    od = __builtin_amdgcn_mfma_f32_32x32x16_bf16(pa3, PK(l3, h3), od, 0, 0, 0);
#undef PK
}
template <bool MSUM>
__device__ __forceinline__ void pv_d0(f32x16* o, f32x16& ol, int vb, bf16x8 pa0, bf16x8 pa1, bf16x8 pa2, bf16x8 pa3) {
    if constexpr (MSUM) {
    const bf16x8 ones = {0x3F80, 0x3F80, 0x3F80, 0x3F80, 0x3F80, 0x3F80, 0x3F80, 0x3F80};
    ol = __builtin_amdgcn_mfma_f32_32x32x16_bf16(pa0, ones, ol, 0, 0, 0); ol = __builtin_amdgcn_mfma_f32_32x32x16_bf16(pa1, ones, ol, 0, 0, 0);
    ol = __builtin_amdgcn_mfma_f32_32x32x16_bf16(pa2, ones, ol, 0, 0, 0); ol = __builtin_amdgcn_mfma_f32_32x32x16_bf16(pa3, ones, ol, 0, 0, 0); }
    pv_one<0>(o[0], vb, pa0, pa1, pa2, pa3); pv_one<1>(o[1], vb, pa0, pa1, pa2, pa3); pv_one<2>(o[2], vb, pa0, pa1, pa2, pa3); pv_one<3>(o[3], vb, pa0, pa1, pa2, pa3);
}
template <int DQK, int C> __device__ __forceinline__ void kfrag_load(bf16x8 (&kf)[8], const LAS unsigned char* Ks, int r32, int hi) {
#pragma unroll
    for (int i = 0; i < 4; ++i) { constexpr int d0b = 4 * C; if (d0b + i < DQK / 16) { const int cb = ((d0b + i) * 16 + hi * 8) * 2;
        kf[2 * i] = *(const LAS bf16x8*)(Ks + kswz<DQK>(r32, cb)); kf[2 * i + 1] = *(const LAS bf16x8*)(Ks + kswz<DQK>(32 + r32, cb)); } }
}
template <int DQK, int C> __device__ __forceinline__ void qkt_mma(f32x16& p0, f32x16& p1, const bf16x8 (&kf)[8], const bf16x8* qr) {
#pragma unroll
    for (int i = 0; i < 4; ++i) { constexpr int d0b = 4 * C; if (d0b + i < DQK / 16) {
        p0 = __builtin_amdgcn_mfma_f32_32x32x16_bf16(kf[2 * i], qr[d0b + i], p0, 0, 0, 0);
        p1 = __builtin_amdgcn_mfma_f32_32x32x16_bf16(kf[2 * i + 1], qr[d0b + i], p1, 0, 0, 0); } }
}
template <int DQK> __device__ __forceinline__ void qkt_rest(f32x16& p0, f32x16& p1, bf16x8 (&kfa)[8], const LAS unsigned char* Ks, const bf16x8* qr, int r32, int hi) {
    p0 = f32x16{}; p1 = f32x16{};
    SBAR(); qkt_mma<DQK, 0>(p0, p1, kfa, qr);
    if constexpr (DQK > 64) { SBAR(); kfrag_load<DQK, 1>(kfa, Ks, r32, hi); SBAR(); qkt_mma<DQK, 1>(p0, p1, kfa, qr); }
    if constexpr (DQK > 128) { SBAR(); kfrag_load<DQK, 2>(kfa, Ks, r32, hi); SBAR(); qkt_mma<DQK, 2>(p0, p1, kfa, qr); }
}
template <bool PRESCALED>
__device__ __forceinline__ void partialSM(f32x16& p0, f32x16& p1, float& m_reg, float& alpha, float C) {
    float pmax = p0[0];
#pragma unroll
    for (int r = 1; r < 16; ++r) pmax = fmaxf(pmax, p0[r]);
#pragma unroll
    for (int r = 0; r < 16; ++r) pmax = fmaxf(pmax, p1[r]);
    { auto rr = __builtin_amdgcn_permlane32_swap(__float_as_uint(pmax), __float_as_uint(pmax), false, false);
      pmax = fmaxf(__uint_as_float(rr[0]), __uint_as_float(rr[1])); }
    if (!PRESCALED) pmax *= C;
    float mn;
    if (__builtin_expect(__all(pmax - m_reg <= THR2), 1)) { mn = m_reg; alpha = 1.f; }
    else { mn = fmaxf(m_reg, pmax); alpha = __builtin_amdgcn_exp2f(m_reg - mn); m_reg = mn; }
    if (PRESCALED) {
#pragma unroll
        for (int r = 0; r < 16; ++r) { p0[r] -= mn; p1[r] -= mn; }
    } else { const float nm = -mn;
#pragma unroll
        for (int r = 0; r < 16; ++r) { p0[r] = fmaf(p0[r], C, nm); p1[r] = fmaf(p1[r], C, nm); } }
#pragma unroll
    for (int r = 0; r < 16; ++r) p0[r] = __builtin_amdgcn_exp2f(p0[r]);
}
template <bool MSUM>
__device__ __forceinline__ void finishSM(f32x16& p0, f32x16& p1, float alpha, float& l_reg, bf16x8& pa0, bf16x8& pa1, bf16x8& pa2, bf16x8& pa3) {
#pragma unroll
    for (int r = 0; r < 16; ++r) p1[r] = __builtin_amdgcn_exp2f(p1[r]);
    if constexpr (!MSUM) { float ps = 0;
#pragma unroll
        for (int r = 0; r < 16; ++r) ps += p0[r];
#pragma unroll
        for (int r = 0; r < 16; ++r) ps += p1[r];
        { auto rr = __builtin_amdgcn_permlane32_swap(__float_as_uint(ps), __float_as_uint(ps), false, false);
          ps = __uint_as_float(rr[0]) + __uint_as_float(rr[1]); }
        l_reg = l_reg * alpha + ps; }
#define PK4(P, BASE, OUT) do { unsigned a0 = cvtpk(P[BASE + 0], P[BASE + 1]), a1 = cvtpk(P[BASE + 2], P[BASE + 3]);   \
    unsigned b0 = cvtpk(P[BASE + 4], P[BASE + 5]), b1 = cvtpk(P[BASE + 6], P[BASE + 7]);                              \
    auto r0 = __builtin_amdgcn_permlane32_swap(a0, b0, false, false); auto r1 = __builtin_amdgcn_permlane32_swap(a1, b1, false, false); \
    u32x4 w = {r0[0], r1[0], r0[1], r1[1]}; OUT = __builtin_bit_cast(bf16x8, w); } while (0)
    PK4(p0, 0, pa0); PK4(p0, 8, pa1); PK4(p1, 0, pa2); PK4(p1, 8, pa3);
#undef PK4
}
struct AttnP { const bf16* Q; const bf16* K; const bf16* V; bf16* O; float C; const u64* mask; const float* cum; const bf16* gate; float lam, oscale; const float* subg; float* O1; };
template <int QRS_, int QHS_, int KRS_, int KHS_, int VRS_, int VHS_, int GRS_> struct Strides { static constexpr int q_rs = QRS_, q_hs = QHS_, k_rs = KRS_, k_hs = KHS_, v_rs = VRS_, v_hs = VHS_, g_rs = GRS_; };
template <int MODE, int DQK, class ST>
__device__ __forceinline__ void attn_unit(const AttnP& A, const int h, const int qb, LAS unsigned char* lds, const int wave) {
    constexpr int SHM_V = 64 * 128 * 2, SHM_K = 64 * DQK * 2, CPR = DQK / 8, KCH = DQK / 64, RING = 3 * SHM_V + 3 * SHM_K;
    const int tid = tid_of(wave), wid = wave,
    lane_m = tid & 63, r32_m = lane_m & 31, hi_m = lane_m >> 5;
    LAS unsigned char* V_lds = lds; LAS unsigned char* K_lds = lds + 3 * SHM_V;
    LAS float* wsf = (LAS float*)(lds + RING) + wid * 64; LAS float* li_l = wsf; LAS float* al_l = wsf + 32;
    LAS float* cumL = (LAS float*)(lds + RING + 2048);
    static_assert(RING + 2048 + (MODE == 3 ? 32768 : 0) <= MISC_OFF, "attention LDS map");
    const int q0 = qb * 256, NT = (q0 + 256) / 64, qrow_m = q0 + wid * 32 + r32_m;
    float cq2 = 0.f;
    if (MODE == 3) {
#pragma unroll 1
        for (int i = tid; i < (q0 + 256) / 4; i += 512) *(LAS f32x4*)(cumL + 4 * i) = *(const f32x4*)(A.cum + (size_t)h * S + 4 * i);
        __syncthreads(); cq2 = cumL[qrow_m]; }
#pragma unroll 1
    for (int pass = 0; pass < (MODE == 2 ? 2 : 1); ++pass) {
    const int qh = MODE == 2 ? 2 * h + pass : h;
    const bf16* Kh = A.K + qh * ST::k_hs; const bf16* Vh = A.V + h * ST::v_hs;
    constexpr bool MSUM = DQK <= 128;
    float l_reg = 0.f; f32x16 o[4] = {}; f32x16 ol = {};
    {
    const int lane = lane_m, r32 = r32_m, hi = hi_m, qrow = qrow_m; float m_reg = -1e30f; bf16x8 qr[DQK / 16];
    { const bf16* Qw = A.Q + (size_t)qrow * ST::q_rs + qh * ST::q_hs + hi * 8;
#pragma unroll
      for (int d0 = 0; d0 < DQK / 16; ++d0) qr[d0] = *(const bf16x8*)(Qw + d0 * 16); }
    const int sr = tid >> 4, sc = (tid & 15) * 8, vst0 = v_st(sr, sc), vst1 = v_st(32 + sr, sc);
    unsigned kgo[KCH]; int klo[KCH];
#pragma unroll
    for (int i = 0; i < KCH; ++i) { const int q = tid + 512 * i, row = q / CPR, ch = q % CPR; kgo[i] = (unsigned)(row * ST::k_rs + ch * 8); klo[i] = kswz<DQK>(row, ch * 16); }
    const unsigned vgo0 = (unsigned)(sr * ST::v_rs + sc), vgo1 = (unsigned)((32 + sr) * ST::v_rs + sc);
    const int vb0 = (int)(unsigned)(uintptr_t)V_lds + v_rd_base(lane);
    struct { bf16x8 vs0, vs1; bf16x8 ks[KCH]; } sr_[1];
#define SLOAD(i, k0) do { const bf16* vb_ = Vh + (size_t)(k0) * ST::v_rs; const bf16* kb_ = Kh + (size_t)(k0) * ST::k_rs; \
    sr_[i].vs0 = *(const bf16x8*)(vb_ + vgo0); sr_[i].vs1 = *(const bf16x8*)(vb_ + vgo1); \
    _Pragma("unroll") for (int _k = 0; _k < KCH; ++_k) sr_[i].ks[_k] = *(const bf16x8*)(kb_ + kgo[_k]); } while (0)
#define SWRITE(b, i) do { *(LAS bf16x8*)(V_lds + (b) * SHM_V + vst0) = sr_[i].vs0; *(LAS bf16x8*)(V_lds + (b) * SHM_V + vst1) = sr_[i].vs1; \
    _Pragma("unroll") for (int _k = 0; _k < KCH; ++_k) *(LAS bf16x8*)(K_lds + (b) * SHM_K + klo[_k]) = sr_[i].ks[_k]; } while (0)
#define SWAIT() asm volatile("s_waitcnt vmcnt(0)" ::: "memory")
#define BAR() asm volatile("s_waitcnt lgkmcnt(0)\n\ts_barrier" ::: "memory")
#define RESC(a) do { if (__any((a) < 1.f)) { int l_; asm volatile("v_mbcnt_lo_u32_b32 %0, -1, 0\n\tv_mbcnt_hi_u32_b32 %0, -1, %0" : "=v"(l_));   \
    if (l_ < 32) al_l[l_] = (a); asm volatile("s_waitcnt lgkmcnt(0)" ::: "memory"); const int h_ = l_ >> 5; \
    _Pragma("unroll") for (int r = 0; r < 16; ++r) { const float f_ = al_l[crow(r, h_)]; if (MSUM) ol[r] *= f_; _Pragma("unroll") for (int d = 0; d < 4; ++d) o[d][r] *= f_; } } } while (0)
    int mG = -1; u64 mw0 = 0, mw1 = 0, mw2 = 0, mw3 = 0;
    u32x4 nx0, nx1;
    { const u32x4* mp = (const u32x4*)((MODE == 1 ? A.mask : (const u64*)A.Q) + (MODE == 1 ? (size_t)qrow * 128 : 0)); nx0 = mp[0]; nx1 = mp[1]; }
#define FIX(P0, P1, T) do { \
    if (MODE == 0 || MODE == 2 || MODE == 3) { if (MODE == 3) { const LAS float* cl = cumL + (T) * 64 + 4 * hi; \
            _Pragma("unroll") for (int jj = 0; jj < 4; ++jj) { const f32x4 c0 = *(const LAS f32x4*)(cl + 8 * jj), c1 = *(const LAS f32x4*)(cl + 32 + 8 * jj); \
                _Pragma("unroll") for (int i = 0; i < 4; ++i) { P0[4 * jj + i] = fmaf(P0[4 * jj + i], A.C, cq2 - c0[i]); P1[4 * jj + i] = fmaf(P1[4 * jj + i], A.C, cq2 - c1[i]); } SBAR(); } } \
        if ((T) >= NT - 4) { const int kb = 64 * ((T) - (NT - 4)) + 4 * hi, qrel = wid * 32 + r32; \
            _Pragma("unroll") for (int r = 0; r < 16; ++r) { const int kv = kb + (r & 3) + 8 * (r >> 2); if (kv > qrel) P0[r] = -INFINITY; if (kv + 32 > qrel) P1[r] = -INFINITY; } } } \
    if (MODE == 1) { if (((T) >> 2) != mG) { mG = (T) >> 2;             \
            mw0 = (u64)nx0.x | ((u64)nx0.y << 32); mw1 = (u64)nx0.z | ((u64)nx0.w << 32); mw2 = (u64)nx1.x | ((u64)nx1.y << 32); mw3 = (u64)nx1.z | ((u64)nx1.w << 32); \
            { const int gn_ = 4 * (mG + 1) < NT ? mG + 1 : mG; const u32x4* mp = (const u32x4*)(A.mask + ((size_t)qrow * 32 + gn_) * 4); nx0 = mp[0]; nx1 = mp[1]; } } \
        const int sh = 16 * ((T) & 3) + hi; const unsigned b0 = (unsigned)(mw0 >> sh), b1 = (unsigned)(mw1 >> sh), b2 = (unsigned)(mw2 >> sh), b3 = (unsigned)(mw3 >> sh); \
        _Pragma("unroll") for (int jj = 0; jj < 4; ++jj) { \
            if (!((b0 >> (2 * jj)) & 1u)) P0[4 * jj + 0] = -INFINITY; if (!((b1 >> (2 * jj)) & 1u)) P0[4 * jj + 1] = -INFINITY; \
            if (!((b2 >> (2 * jj)) & 1u)) P0[4 * jj + 2] = -INFINITY; if (!((b3 >> (2 * jj)) & 1u)) P0[4 * jj + 3] = -INFINITY; \
            if (!((b0 >> (8 + 2 * jj)) & 1u)) P1[4 * jj + 0] = -INFINITY; if (!((b1 >> (8 + 2 * jj)) & 1u)) P1[4 * jj + 1] = -INFINITY; \
            if (!((b2 >> (8 + 2 * jj)) & 1u)) P1[4 * jj + 2] = -INFINITY; if (!((b3 >> (8 + 2 * jj)) & 1u)) P1[4 * jj + 3] = -INFINITY; } } } while (0)
    constexpr bool PRE = (MODE == 3);
    {
        const int grp = wid >> 2;
        f32x16 p0, p1; float al = 1.f; bf16x8 pa0, pa1, pa2, pa3;
        SLOAD(0, 0); SWAIT(); SWRITE(0, 0); SLOAD(0, 64); BAR();
        if (grp == 1) BAR();
        bf16x8 kfa[8];
        SWAIT(); SWRITE(1, 0); kfrag_load<DQK, 0>(kfa, K_lds, r32, hi); SBAR(); qkt_rest<DQK>(p0, p1, kfa, K_lds, qr, r32, hi); BAR();
        int s_prev = 0, s_cur = 1, s_next = 2;
#pragma unroll 1
        for (int m = 1; m < NT; ++m) {
            if (m + 1 < NT) SLOAD(0, (m + 1) * 64);
            SBAR(); FIX(p0, p1, m - 1); partialSM<PRE>(p0, p1, m_reg, al, A.C); finishSM<MSUM>(p0, p1, al, l_reg, pa0, pa1, pa2, pa3); BAR();
            if (m + 1 < NT) { SWAIT(); SWRITE(s_next, 0); }
            kfrag_load<DQK, 0>(kfa, K_lds + s_cur * SHM_K, r32, hi);
            RESC(al); SBAR();
            pv_d0<MSUM>(o, ol, vb0 + s_prev * SHM_V, pa0, pa1, pa2, pa3); SBAR();
            qkt_rest<DQK>(p0, p1, kfa, K_lds + s_cur * SHM_K, qr, r32, hi); BAR();
            { const int t_ = s_prev; s_prev = s_cur; s_cur = s_next; s_next = t_; }
        }
        SBAR(); FIX(p0, p1, NT - 1); partialSM<PRE>(p0, p1, m_reg, al, A.C); finishSM<MSUM>(p0, p1, al, l_reg, pa0, pa1, pa2, pa3); BAR();
        RESC(al); SBAR();
        pv_d0<MSUM>(o, ol, vb0 + s_prev * SHM_V, pa0, pa1, pa2, pa3);
        if (grp == 0) BAR();
    }
    }
    asm volatile("s_waitcnt vmcnt(0)" ::: "memory");
    int lane_e; asm volatile("v_mbcnt_lo_u32_b32 %0, -1, 0\n\tv_mbcnt_hi_u32_b32 %0, -1, %0" : "=v"(lane_e));
    const int r32 = lane_e & 31, hi = lane_e >> 5, lane = lane_e;
    float rli[16];
    if constexpr (MSUM) {
#pragma unroll
        for (int r = 0; r < 16; ++r) rli[r] = __builtin_amdgcn_rcpf(ol[r]);
    } else { if (hi == 0) li_l[r32] = l_reg; asm volatile("s_waitcnt lgkmcnt(0)" ::: "memory");
#pragma unroll
        for (int r = 0; r < 16; ++r) rli[r] = __builtin_amdgcn_rcpf(li_l[crow(r, hi)]); }
#pragma unroll
    for (int d0 = 0; d0 < 4; ++d0)
#pragma unroll
        for (int r = 0; r < 16; ++r) o[d0][r] *= rli[r];
    if (MODE == 2 && pass == 0) {
        float* Ow = A.O1 + (size_t)(q0 + wid * 32) * D + h * 128;
#pragma unroll
        for (int r = 0; r < 16; ++r)
#pragma unroll
            for (int d0 = 0; d0 < 4; ++d0) Ow[(size_t)crow(r, hi) * D + d0 * 32 + r32] = o[d0][r];
        asm volatile("s_waitcnt vmcnt(0)" ::: "memory"); __syncthreads();
        continue;
    }
    if (MODE == 2) {
        const float* Ow = A.O1 + (size_t)(q0 + wid * 32) * D + h * 128;
#pragma unroll
        for (int r = 0; r < 16; ++r) { float ss = 0.f;
#pragma unroll
            for (int d0 = 0; d0 < 4; ++d0) { const float v = Ow[(size_t)crow(r, hi) * D + d0 * 32 + r32] - A.lam * o[d0][r]; o[d0][r] = v; ss += v * v; }
#pragma unroll
            for (int off = 16; off >= 1; off >>= 1) ss += __shfl_xor(ss, off);
            const float rs = rsqrtf(ss * (1.f / 128.f) + EPS) * A.oscale;
#pragma unroll
            for (int d0 = 0; d0 < 4; ++d0) o[d0][r] *= rs * A.subg[d0 * 32 + r32]; }
    }
    __syncthreads();
    { LAS unsigned char* stg = lds + wid * (32 * 272);
#pragma unroll
      for (int r = 0; r < 16; ++r)
#pragma unroll
          for (int d0 = 0; d0 < 4; ++d0) *(LAS unsigned short*)(stg + crow(r, hi) * 272 + (d0 * 32 + r32) * 2) = (unsigned short)f2bf(o[d0][r]);
      asm volatile("s_waitcnt lgkmcnt(0)" ::: "memory");
#pragma unroll
      for (int i = 0; i < 8; ++i) { const int row = i * 4 + (lane >> 4), ch = lane & 15; u32x4 v = *(const LAS u32x4*)(stg + row * 272 + ch * 16);
          const size_t grow = (size_t)(q0 + wid * 32 + row);
          if (MODE == 3) { const u32x4 gv = *(const u32x4*)(A.gate + grow * ST::g_rs + h * 128 + ch * 8);
#pragma unroll
              for (int e = 0; e < 4; ++e) { const float g0 = bf2f(gv[e] & 0xffffu), g1 = bf2f(gv[e] >> 16), x0 = bf2f(v[e] & 0xffffu), x1 = bf2f(v[e] >> 16);
                  v[e] = pk2(x0 * __builtin_amdgcn_rcpf(1.f + __expf(-g0)), x1 * __builtin_amdgcn_rcpf(1.f + __expf(-g1))); } }
          *(u32x4*)(A.O + grow * D + h * 128 + ch * 8) = v; } }
    asm volatile("s_waitcnt vmcnt(0) lgkmcnt(0)" ::: "memory"); __syncthreads();
    }
#undef SLOAD
#undef SWRITE
#undef SWAIT
#undef BAR
#undef RESC
#undef FIX
}
template <int MODE, int DQK, class ST>
__device__ __forceinline__ void attn_phase(const AttnP& A, LAS unsigned char* lds, int blk, int G, int wave) {
    const int vcu = (G % 8 == 0) ? (blk % 8) * (G / 8) + blk / 8 : blk;
    for (int p = vcu; p < 256; p += G) { const int h = p >> 4, s2 = p & 15;
        attn_unit<MODE, DQK, ST>(A, h, 31 - s2, lds, wave); attn_unit<MODE, DQK, ST>(A, h, s2, lds, wave); }
}
#undef SBAR
}

__device__ __forceinline__ void score_mfma(const bf16* P, const float* IW, float* SIDX, const Ctx& c) {
#pragma unroll 1
    for (int task = c.gw; task < 2304; task += c.ngw) {
        int lane = c.lane; asm volatile("" : "+v"(lane));
        const int l16 = lane & 15, kg = lane >> 4;
        int j = 0;
#pragma unroll
        for (int jj = 1; jj < 8; ++jj) if (task >= 32 * jj * (jj + 1)) j = jj;
        const int local = task - 32 * j * (j + 1), qg = 64 * j + local / (j + 1), kc = local % (j + 1), t0 = 16 * qg;
        const bf16* qp = P + (size_t)(t0 + l16) * N_DSA_IN + 6144 + 8 * kg;
        bf16x8 bq[16][2]; float w[16];
#pragma unroll
        for (int h = 0; h < 16; ++h) { bq[h][0] = *(const bf16x8*)(qp + h * 64); bq[h][1] = *(const bf16x8*)(qp + h * 64 + 32); w[h] = IW[(t0 + l16) * 16 + h] * 0.0625f; }
        bf16x8 bl[2];
#pragma unroll
        for (int u2 = 0; u2 < 2; ++u2) { float sacc[8] = {0.f, 0.f, 0.f, 0.f, 0.f, 0.f, 0.f, 0.f};
#pragma unroll
            for (int h = 0; h < 16; ++h)
#pragma unroll
                for (int e = 0; e < 8; ++e) sacc[e] += w[h] * bf2f((unsigned short)bq[h][u2][e]);
            u32x4 pk; pk.x = pk2(sacc[0], sacc[1]); pk.y = pk2(sacc[2], sacc[3]); pk.z = pk2(sacc[4], sacc[5]); pk.w = pk2(sacc[6], sacc[7]); bl[u2] = __builtin_bit_cast(bf16x8, pk); }
        const int kend = (1024 * kc + 1024) < (t0 + 16) ? (1024 * kc + 1024) : (t0 + 16);
        const bf16* kp = P + (size_t)(1024 * kc + l16) * N_DSA_IN + 7168 + 8 * kg;
        float* op = SIDX + (size_t)(t0 + l16) * S + 1024 * kc + 4 * kg;
        bf16x8 a0 = *(const bf16x8*)kp, a1 = *(const bf16x8*)(kp + 32);
        for (int k0 = 1024 * kc; k0 < kend; k0 += 16) {
            const bf16x8 c0 = a0, c1 = a1;
            if (k0 + 16 < kend) { kp += (size_t)16 * N_DSA_IN; a0 = *(const bf16x8*)kp; a1 = *(const bf16x8*)(kp + 32); }
            f32x4 acc = {0.f, 0.f, 0.f, 0.f};
            acc = __builtin_amdgcn_mfma_f32_16x16x32_bf16(c0, bl[0], acc, 0, 0, 0);
            acc = __builtin_amdgcn_mfma_f32_16x16x32_bf16(c1, bl[1], acc, 0, 0, 0);
            f32x4 dc = {0.f, 0.f, 0.f, 0.f}, dm = {0.f, 0.f, 0.f, 0.f};
            dc = __builtin_amdgcn_mfma_f32_16x16x32_bf16(c0, bq[0][0], dc, 0, 0, 0); dm = __builtin_amdgcn_mfma_f32_16x16x32_bf16(c0, bq[1][0], dm, 0, 0, 0);
            dc = __builtin_amdgcn_mfma_f32_16x16x32_bf16(c1, bq[0][1], dc, 0, 0, 0); dm = __builtin_amdgcn_mfma_f32_16x16x32_bf16(c1, bq[1][1], dm, 0, 0, 0);
#pragma unroll
            for (int h = 0; h < 16; ++h) { f32x4 dn = {0.f, 0.f, 0.f, 0.f};
                if (h + 2 < 16) { dn = __builtin_amdgcn_mfma_f32_16x16x32_bf16(c0, bq[h + 2 < 16 ? h + 2 : 15][0], dn, 0, 0, 0);
                                  dn = __builtin_amdgcn_mfma_f32_16x16x32_bf16(c1, bq[h + 2 < 16 ? h + 2 : 15][1], dn, 0, 0, 0); }
                else asm volatile("s_nop 7\n\ts_nop 7\n\ts_nop 7" ::: "memory");
                if (h == 0) { __builtin_amdgcn_sched_barrier(0); asm volatile("s_nop 7\n\ts_nop 7\n\ts_nop 7" ::: "memory"); }
                __builtin_amdgcn_sched_barrier(0);
#pragma unroll
                for (int i = 0; i < 4; ++i) asm volatile("v_fma_f32 %0, %1, |%2|, %0" : "+v"(acc[i]) : "v"(w[h]), "v"(dc[i]));
                __builtin_amdgcn_sched_barrier(0);
                dc = dm; dm = dn; }
            *(f32x4*)op = acc; op += 16;
        }
    }
}
__device__ __forceinline__ void select_phase(const float* SIDX, u64* MASK, const Ctx& c) {
    const int q4 = c.tid >> 7, t128 = c.tid & 127, w2 = t128 >> 6, lane = c.lane;
    LAS unsigned* hist = (LAS unsigned*)(c.lds + q4 * 16384);
    volatile LAS unsigned* wt = (volatile LAS unsigned*)(c.lds + 65536 + q4 * 64);
    u32x4 nv[16];
    { const int t0_ = 4 * c.blk + q4;
#pragma unroll
      for (int j = 0; j < 16; ++j) { const int base = 512 * j + 4 * t128; nv[j] = *(const u32x4*)(SIDX + (size_t)t0_ * S + (base <= t0_ ? base : 0)); } }
#pragma unroll 1
    for (int grp = c.blk; grp < S / 4; grp += c.G) {
        const int t = 4 * grp + q4;
        unsigned u[64];
#pragma unroll
        for (int j = 0; j < 16; ++j) { const int base = 512 * j + 4 * t128;
            const u32x4 v = nv[j];
#pragma unroll
            for (int e = 0; e < 4; ++e) { const unsigned b = v[e]; const unsigned o = (b & 0x80000000u) ? ~b : (b | 0x80000000u);
                u[4 * j + e] = (base + e <= t) ? o : 0u; } }
        { const int gn_ = grp + c.G < S / 4 ? grp + c.G : grp; const int tn_ = 4 * gn_ + q4;
#pragma unroll
          for (int j = 0; j < 16; ++j) { const int base = 512 * j + 4 * t128; nv[j] = *(const u32x4*)(SIDX + (size_t)tn_ * S + (base <= tn_ ? base : 0)); } }
        unsigned krem = (unsigned)(t + 1 < 256 ? t + 1 : 256), prefix = 0u;
        unsigned lmin;
        { unsigned m1 = 0u, m2 = 0u;
#pragma unroll
          for (int j = 0; j < 16; ++j) if (512 * j <= t)
#pragma unroll
            for (int e = 0; e < 4; ++e) { const int i = 4 * j + e; const unsigned lo = u[i] < m1 ? u[i] : m1; m2 = lo > m2 ? lo : m2; m1 = u[i] > m1 ? u[i] : m1; }
          unsigned lm = m2;
#pragma unroll
          for (int o = 32; o >= 1; o >>= 1) { const unsigned n = __shfl_xor(lm, o); lm = n < lm ? n : lm; }
          if (lane == 0) wt[12 + w2] = lm;
          __syncthreads();
          lmin = wt[12]; { const unsigned a1 = wt[13]; lmin = a1 < lmin ? a1 : lmin; } }
#pragma unroll
        for (int pass = 0; pass < 3; ++pass) {
            const int shift = pass == 0 ? 20 : (pass == 1 ? 8 : 0); const unsigned dmask = pass == 2 ? 0xFFu : 0xFFFu;
            const int pshift = pass == 0 ? 32 : (pass == 1 ? 20 : 8);
#pragma unroll
            for (int i = 0; i < 32; ++i) hist[t128 + 128 * i] = 0u;
            __syncthreads();
#pragma unroll
            for (int j = 0; j < 16; ++j) if (512 * j <= t)
#pragma unroll
              for (int e = 0; e < 4; ++e) { const int i = 4 * j + e; const bool match = pass == 0 ? (u[i] >= lmin && u[i] != 0u) : ((u[i] >> pshift) == prefix && u[i] >= lmin);
                if (match) atomicAdd((unsigned*)&hist[(u[i] >> shift) & dmask], 1u); }
            __syncthreads();
            unsigned loc = 0u;
#pragma unroll
            for (int i = 0; i < 32; ++i) loc += hist[32 * t128 + i];
            unsigned incl = loc;
#pragma unroll
            for (int o = 1; o < 64; o <<= 1) { const unsigned n = __shfl_down(incl, o); if (lane + o < 64) incl += n; }
            if (lane == 0) wt[w2] = incl;
            __syncthreads();
            const unsigned above = w2 == 0 ? wt[1] : 0u;
            incl += above; const unsigned excl = incl - loc;
            if (excl < krem && krem <= incl) { unsigned cnt = excl;
                for (int b = 31; b >= 0; --b) { const unsigned hb = hist[32 * t128 + b];
                    if (cnt + hb >= krem) { wt[8] = (unsigned)(32 * t128 + b); wt[9] = krem - cnt; break; } cnt += hb; } }
            __syncthreads();
            prefix = (pass == 0) ? wt[8] : (pass == 1 ? ((prefix << 12) | wt[8]) : ((prefix << 8) | wt[8]));
            krem = wt[9];
        }
        const unsigned thr = prefix;
#pragma unroll
        for (int j = 0; j < 16; ++j) { if (512 * j <= t) {
#pragma unroll
            for (int e = 0; e < 4; ++e) { const u64 bal = __ballot(u[4 * j + e] >= thr && u[4 * j + e] != 0u);
                if (lane == 0) MASK[((size_t)t * 32 + (2 * j + w2)) * 4 + e] = bal; } } }
        __syncthreads();
    }
}


__device__ __forceinline__ void ph_cumsum(const float* logf, float* cum, const Ctx& c) {
    if (c.blk >= NH) return;
    LAS float* wsum = (LAS float*)c.lds; const int h = c.blk, tid = c.tid;
    float v[16];
    { const f32x4* lp = (const f32x4*)(logf + (size_t)h * S + 16 * tid);
#pragma unroll
      for (int k = 0; k < 4; ++k) { const f32x4 x = lp[k]; v[4 * k] = x.x; v[4 * k + 1] = x.y; v[4 * k + 2] = x.z; v[4 * k + 3] = x.w; } }
#pragma unroll
    for (int k = 1; k < 16; ++k) v[k] += v[k - 1];
    const float tot = v[15]; float incl = tot;
#pragma unroll
    for (int o2 = 1; o2 < 64; o2 <<= 1) { const float nb = __shfl_up(incl, o2); if (c.lane >= o2) incl += nb; }
    if (c.lane == 63) wsum[c.wave] = incl;
    __syncthreads();
    float base = incl - tot;
    for (int w = 0; w < c.wave; ++w) base += wsum[w];
    f32x4* op = (f32x4*)(cum + (size_t)h * S + 16 * tid);
#pragma unroll
    for (int k = 0; k < 4; ++k) op[k] = (f32x4){(v[4 * k] + base) * fa::LOG2E, (v[4 * k + 1] + base) * fa::LOG2E, (v[4 * k + 2] + base) * fa::LOG2E, (v[4 * k + 3] + base) * fa::LOG2E};
}
constexpr int NPHASE = 32;
#ifndef MK_PER_PHASE
#define MK_PER_PHASE 0
#endif
__global__ void __launch_bounds__(512, 2) mega(Args a) {
    extern __shared__ __attribute__((aligned(16))) unsigned char lds_raw[];
    Ctx c; c.lds = (LAS unsigned char*)lds_raw; c.tid = threadIdx.x; c.lane = c.tid & 63; c.wave = __builtin_amdgcn_readfirstlane(c.tid >> 6);
    c.G = gridDim.x; c.blk = blockIdx.x; c.gw = c.blk * 8 + c.wave; c.ngw = c.G * 8;
    volatile LAS unsigned* MISC = (volatile LAS unsigned*)(c.lds + MISC_OFF);
    if (c.tid < 32) MISC[c.tid] = 0u;
    __syncthreads();
    unsigned* ctl = (unsigned*)(a.ws + WS_CTL);
    XcdBarrier bar; bar.bar = ctl + CW_BAR; bar.x = 0; bar.st = nullptr; bar.wave = c.wave;
    const int lo = a.ph_lo, hi = a.ph_hi;
    if (hi - lo > 1) bar = xcd_barrier_post(ctl + CW_BAR, MISC + 8, c.wave);
#define IN(k) (lo <= (k) && (k) < hi && (fresh(c), ws = launder_ptr(a.ws), true))
#define SEAM(k) do { if (lo <= (k) && (k) + 1 < hi) xcd_barrier(bar); } while (0)
    unsigned char* ws = a.ws;
#define mod ((float*)(ws + WS_MOD))
#define XB ((bf16*)(ws + WS_XB))
#define P ((bf16*)(ws + WS_P))
#define Ob ((bf16*)(ws + WS_O))
#define HID ((bf16*)(ws + WS_HID))
#define STAT ((float*)(ws + WS_STAT))
#define BIAS ((float*)(ws + WS_BIAS))
#define BIASP ((const float*)(ws + WS_BIASP))
#define xin ((const float*)a.in[I_X])
#define out (a.out)
#define R64 ((const f32x2*)(ws + WS_ROPE64))
#define R32 ((const f32x2*)(ws + WS_ROPE32))
#define R16 ((const f32x2*)(ws + WS_ROPE16))
#define PM ((bf16*)(ws + WS_PM))
#define CN ((bf16*)(ws + WS_CN))
#define QRAW P
#define KVRAW ((bf16*)(ws + WS_P + 48 * MiB))
#define Qb ((bf16*)(ws + WS_Q))
#define Kb ((bf16*)(ws + WS_K))
#define IW ((float*)(ws + WS_IW))
#define SIDX ((float*)(ws + WS_SIDX))
#define MASK ((u64*)(ws + WS_MASK))
#define LOGF ((float*)(ws + WS_LOGF))

    if (IN(0)) ph_phase0(a, c);
    SEAM(0);
    if (IN(1)) ph_modfinal(a, c);
    SEAM(1);
    if (IN(2)) ph_weights(a, c);
    SEAM(2);

#define WIN(PH, WOFF, NN, BO, OUTP, NHT) \
    if (IN(PH)) { if ((PH) == 3) { bias_all(BIASP, BIAS, N_MLA_IN, c); bias_reduce(BIASP + (BO), BIAS + (BO), S, NN, c.G, c.blk, c.wave, NHT); } pg8::EpiStoreP EP{OUTP, NN, STAT, BIAS + (BO)}; GEMM_SITE(EP, XB, D, (const bf16*)(ws + (WOFF)), D, S, NN, D, NHT); } \
    SEAM(PH);
#define WOUT(L, PH, XSRC) \
    if (IN(PH)) { pg8::EpiResP<false> EP{XB, (bf16*)(ws + WS_XL), mod + (L) * NMOD + 2 * D, STAT, nullptr}; GEMM_SITE(EP, Ob, D, (const bf16*)(ws + WS_W_OUT + (size_t)(L) * 8 * MiB), D, S, D, D, 0); } \
    SEAM(PH);
#define FFN_PHASES(L, P0) \
    if (IN(P0)) { pg8::EpiSwigluP EP{HID, STAT, BIAS + BO_GU + (L) * 2 * FF}; \
        GEMM_SITE(EP, XB, D, (const bf16*)(ws + WS_W_GU + (size_t)(L) * 44 * MiB), D, S, 2 * FF, D, 4); } \
    SEAM(P0); \
    if (IN(P0 + 1)) { pg8::EpiResP<(L) == 3> EP{XB, (bf16*)(ws + WS_XL), mod + (L) * NMOD + 5 * D, STAT, out}; GEMM_SITE(EP, HID, FF, (const bf16*)(ws + WS_W_DN + (size_t)(L) * 22 * MiB), FF, S, D, FF, 0); } \
    if ((P0) + 1 < NPHASE - 1) SEAM(P0 + 1);

    WIN(3, WS_W_MLA_IN, N_MLA_IN, BO_MLA, PM, 0)
    if (IN(4)) {
        const float* gq = (const float*)a.in[I_MLA_QAG]; const float* gkv = (const float*)a.in[I_MLA_KVAG];
        const int hf = c.lane >> 5, l32 = c.lane & 31;
        float g[16];
        { const float* gp = (hf ? gkv : gq) + l32 * 16;
#pragma unroll
          for (int e = 0; e < 4; ++e) { const f32x4 gv = *(const f32x4*)(gp + 4 * e); g[4 * e] = gv.x; g[4 * e + 1] = gv.y; g[4 * e + 2] = gv.z; g[4 * e + 3] = gv.w; } }
        bf16x8 n0, n1;
        { const bf16* src = PM + (size_t)(c.gw < S ? c.gw : 0) * N_MLA_IN + hf * 512 + l32 * 16; n0 = *(const bf16x8*)src; n1 = *(const bf16x8*)(src + 8); }
        for (int t = c.gw; t < S; t += c.ngw) {
            const bf16x8 v0 = n0, v1 = n1; float x[16]; float ss = 0.f;
            { const int tn = t + c.ngw < S ? t + c.ngw : t; const bf16* src = PM + (size_t)tn * N_MLA_IN + hf * 512 + l32 * 16; n0 = *(const bf16x8*)src; n1 = *(const bf16x8*)(src + 8); }
#pragma unroll
            for (int e = 0; e < 8; ++e) { x[e] = bf2f((unsigned short)v0[e]); x[8 + e] = bf2f((unsigned short)v1[e]); }
#pragma unroll
            for (int e = 0; e < 16; ++e) ss += x[e] * x[e];
#pragma unroll
            for (int o = 16; o >= 1; o >>= 1) ss += __shfl_xor(ss, o);
            const float r = rsqrtf(ss * (1.f / 512.f) + EPS);
            u32x4 o0, o1;
            o0.x = pk2(x[0] * r * g[0], x[1] * r * g[1]); o0.y = pk2(x[2] * r * g[2], x[3] * r * g[3]); o0.z = pk2(x[4] * r * g[4], x[5] * r * g[5]); o0.w = pk2(x[6] * r * g[6], x[7] * r * g[7]);
            o1.x = pk2(x[8] * r * g[8], x[9] * r * g[9]); o1.y = pk2(x[10] * r * g[10], x[11] * r * g[11]); o1.z = pk2(x[12] * r * g[12], x[13] * r * g[13]); o1.w = pk2(x[14] * r * g[14], x[15] * r * g[15]);
            bf16* dst = CN + (size_t)t * 1024 + hf * 512 + l32 * 16; *(u32x4*)dst = o0; *(u32x4*)(dst + 8) = o1;
        }
    }
    SEAM(4);
    if (IN(5)) {
        { pg8::EpiStoreP EP{QRAW, 3072, nullptr, nullptr}; GEMM_SITE(EP, CN, 1024, (const bf16*)(ws + WS_W_MLA_QB), 512, S, 3072, 512, 4); }
        { pg8::EpiStoreP EP{KVRAW, 4096, nullptr, nullptr}; GEMM_SITE(EP, CN + 512, 1024, (const bf16*)(ws + WS_W_MLA_KVB), 512, S, 4096, 512, 0); }
    }
    SEAM(5);
    if (IN(6)) {
        const float* gq = (const float*)a.in[I_MLA_QG]; const float* gk = (const float*)a.in[I_MLA_KG];
        const int hl = c.lane >> 3, part = c.lane & 7;
        H8G<192> Gq, Gk; h8_gain<192>(Gq, gq, part); h8_gain<192>(Gk, gk, part);
        H8R<192> nq, nk; H8C nc;
#define MLA_LOAD(IT) do { const int t_ = (IT) >> 1, h_ = ((IT) & 1) * 8 + hl; const bf16* qs_ = QRAW + (size_t)t_ * 3072 + h_ * 192 + part * 8; \
            h8_load<192>(nq, qs_, qs_ + 64); h8_load<192>(nk, PM + (size_t)t_ * N_MLA_IN + 1024 + part * 8, KVRAW + (size_t)t_ * 4096 + h_ * 256 + part * 8); h8_rope<64>(nc, R64 + t_ * 32, part); } while (0)
        MLA_LOAD(c.gw < S * 2 ? c.gw : 0);
        for (int it = c.gw; it < S * 2; it += c.ngw) { const int t = it >> 1, h = (it & 1) * 8 + hl;
            const H8R<192> aq = nq, ak = nk; const H8C ac = nc;
            { const int itn = it + c.ngw < S * 2 ? it + c.ngw : it; MLA_LOAD(itn); }
            h8_finish<192, 64, true>(aq, Qb + (size_t)t * 3072 + h * 192 + part * 8, Gq, ac, c.lane);
            h8_finish<192, 64, true>(ak, Kb + (size_t)t * 3072 + h * 192 + part * 8, Gk, ac, c.lane); }
#undef MLA_LOAD
    }
    SEAM(6);
    if (IN(7)) { fa::AttnP A{Qb, Kb, KVRAW + 128, Ob, 0.07216878364870322f * fa::LOG2E, nullptr, nullptr, nullptr, 0.f, 0.f, nullptr, nullptr}; fa::attn_phase<0, 192, fa::Strides<3072, 192, 3072, 192, 4096, 256, 0>>(A, c.lds, c.blk, c.G, c.wave); }
    SEAM(7);
    WOUT(0, 8, xin)
    FFN_PHASES(0, 9)

    WIN(11, WS_W_DSA_IN, N_DSA_IN, BO_DSA, P, 0)
    if (IN(12)) {
        const float* gq = (const float*)a.in[I_DSA_QG]; const float* gk = (const float*)a.in[I_DSA_KG]; const float* gik = (const float*)a.in[I_DSA_IKG];
        const int hl = c.lane >> 3, part = c.lane & 7;
        H8G<128> Gq, Gk; h8_gain<128>(Gq, gq, part); h8_gain<128>(Gk, gk, part); const H8G<64> G0{}; H8G<64> Gik; h8_gain<64>(Gik, gik, part);
        H8R<128> nq[2], nk[2]; H8R<64> ni[2], nik; H8C nc32, nc16; unsigned nw;
#define DSA_LOAD(T) do { const bf16* row_ = P + (size_t)(T) * N_DSA_IN; _Pragma("unroll") for (int hb = 0; hb < 2; ++hb) { const bf16* q_ = row_ + (hb * 8 + hl) * 128 + part * 8; \
            h8_load<128>(nq[hb], q_, q_ + 64); h8_load<128>(nk[hb], q_ + 2048, q_ + 2048 + 64); h8_load<64>(ni[hb], row_ + 6144 + (hb * 8 + hl) * 64 + part * 8, nullptr); } \
            h8_load<64>(nik, row_ + 7168 + part * 8, nullptr); nw = ((const unsigned short*)row_)[7232 + (c.lane & 15)]; \
            h8_rope<32>(nc32, R32 + (T) * 16, part); h8_rope<16>(nc16, R16 + (T) * 8, part); } while (0)
        DSA_LOAD(c.gw < S ? c.gw : 0);
        for (int t = c.gw; t < S; t += c.ngw) { bf16* row = P + (size_t)t * N_DSA_IN;
            H8R<128> aq[2] = {nq[0], nq[1]}, ak[2] = {nk[0], nk[1]}; H8R<64> ai[2] = {ni[0], ni[1]}; const H8R<64> aik = nik; const unsigned aw = nw; const H8C ac32 = nc32, ac16 = nc16;
            { const int tn = t + c.ngw < S ? t + c.ngw : t; DSA_LOAD(tn); }
#pragma unroll
            for (int hb = 0; hb < 2; ++hb) { bf16* q = row + (hb * 8 + hl) * 128 + part * 8; bf16* k = q + 2048; bf16* iq = row + 6144 + (hb * 8 + hl) * 64 + part * 8;
                h8_finish<128, 32, true>(aq[hb], q, Gq, ac32, c.lane);
                h8_finish<128, 32, true>(ak[hb], k, Gk, ac32, c.lane);
                h8_finish<64, 16, false>(ai[hb], iq, G0, ac16, c.lane); }
            h8_finish<64, 16, true>(aik, c.lane < 8 ? row + 7168 + part * 8 : (bf16*)(ws + WS_O1) + c.lane * 8, Gik, ac16, c.lane);
            if (c.lane < 16) IW[t * 16 + c.lane] = bf2f(aw) * 0.25f; }
#undef DSA_LOAD
    }
    SEAM(12);
    if (IN(13)) score_mfma(P, IW, SIDX, c);
    SEAM(13);
    if (IN(14)) select_phase(SIDX, MASK, c);
    SEAM(14);
    if (IN(15)) { fa::AttnP A{P, P + 2048, P + 4096, Ob, 0.08838834764831845f * fa::LOG2E, MASK, nullptr, nullptr, 0.f, 0.f, nullptr, nullptr}; fa::attn_phase<1, 128, fa::Strides<N_DSA_IN, 128, N_DSA_IN, 128, N_DSA_IN, 128, 0>>(A, c.lds, c.blk, c.G, c.wave); }
    SEAM(15);
    WOUT(1, 16, out)
    FFN_PHASES(1, 17)

    WIN(19, WS_W_DIFF_IN, N_DIFF_IN, BO_DIFF, P, 0)
    if (IN(20)) {
        const float* gq = (const float*)a.in[I_DIFF_QG]; const float* gk = (const float*)a.in[I_DIFF_KG];
        const int hl = c.lane >> 3, part = c.lane & 7;
        H8G<64> Gq, Gk; h8_gain<64>(Gq, gq, part); h8_gain<64>(Gk, gk, part);
        H8R<64> nq[4], nk[4]; H8C nc;
#define DIFF_LOAD(T) do { const bf16* row_ = P + (size_t)(T) * N_DIFF_IN; _Pragma("unroll") for (int hb = 0; hb < 4; ++hb) { const bf16* q_ = row_ + (hb * 8 + hl) * 64 + part * 8; \
            h8_load<64>(nq[hb], q_, nullptr); h8_load<64>(nk[hb], q_ + 2048, nullptr); } h8_rope<16>(nc, R16 + (T) * 8, part); } while (0)
        DIFF_LOAD(c.gw < S ? c.gw : 0);
        for (int t = c.gw; t < S; t += c.ngw) { bf16* row = P + (size_t)t * N_DIFF_IN;
            H8R<64> aq[4] = {nq[0], nq[1], nq[2], nq[3]}, ak[4] = {nk[0], nk[1], nk[2], nk[3]}; const H8C ac = nc;
            { const int tn = t + c.ngw < S ? t + c.ngw : t; DIFF_LOAD(tn); }
#pragma unroll
            for (int hb = 0; hb < 4; ++hb) { bf16* q = row + (hb * 8 + hl) * 64 + part * 8; bf16* k = q + 2048;
                h8_finish<64, 16, true>(aq[hb], q, Gq, ac, c.lane);
                h8_finish<64, 16, true>(ak[hb], k, Gk, ac, c.lane); } }
#undef DIFF_LOAD
    }
    SEAM(20);
    if (IN(21)) {
        const float* lq1 = (const float*)a.in[I_DIFF_LQ1]; const float* lk1 = (const float*)a.in[I_DIFF_LK1];
        const float* lq2 = (const float*)a.in[I_DIFF_LQ2]; const float* lk2 = (const float*)a.in[I_DIFF_LK2];
        float d1 = 0.f, d2 = 0.f;
        for (int i = 0; i < 64; ++i) { d1 += lq1[i] * lk1[i]; d2 += lq2[i] * lk2[i]; }
        const float lam_init = 0.8f - 0.6f * 0.5488116360940264f;
        const float lam = __expf(d1) - __expf(d2) + lam_init;
        fa::AttnP A{P, P + 2048, P + 4096, Ob, 0.125f * fa::LOG2E, nullptr, nullptr, nullptr, lam, 1.f - lam_init, (const float*)a.in[I_DIFF_SUBG], (float*)(ws + WS_O1)};
        fa::attn_phase<2, 64, fa::Strides<N_DIFF_IN, 64, N_DIFF_IN, 64, N_DIFF_IN, 128, 0>>(A, c.lds, c.blk, c.G, c.wave);
    }
    SEAM(21);
    WOUT(2, 22, out)
    FFN_PHASES(2, 23)

    WIN(25, WS_W_FOX_IN, N_FOX_IN, BO_FOX, P, 1)
    if (IN(26)) {
        const float* gq = (const float*)a.in[I_FOX_QG]; const float* gk = (const float*)a.in[I_FOX_KG]; const float* bfv = (const float*)a.in[I_FOX_BF];
        const int hl = c.lane >> 3, part = c.lane & 7;
        H8G<128> Gq, Gk; h8_gain<128>(Gq, gq, part); h8_gain<128>(Gk, gk, part); const H8C C0{};
        H8R<128> nq[2], nk[2]; unsigned nz;
#define FOX_LOAD(T) do { const bf16* row_ = P + (size_t)(T) * N_FOX_IN; _Pragma("unroll") for (int hb = 0; hb < 2; ++hb) { const bf16* q_ = row_ + (hb * 8 + hl) * 128 + part * 8; \
            h8_load<128>(nq[hb], q_, q_ + 64); h8_load<128>(nk[hb], q_ + 2048, q_ + 2048 + 64); } nz = ((const unsigned short*)row_)[8192 + (c.lane & 15)]; } while (0)
        FOX_LOAD(c.gw < S ? c.gw : 0);
        for (int t = c.gw; t < S; t += c.ngw) { bf16* row = P + (size_t)t * N_FOX_IN;
            H8R<128> aq[2] = {nq[0], nq[1]}, ak[2] = {nk[0], nk[1]}; const unsigned az = nz;
            { const int tn = t + c.ngw < S ? t + c.ngw : t; FOX_LOAD(tn); }
#pragma unroll
            for (int hb = 0; hb < 2; ++hb) { bf16* q = row + (hb * 8 + hl) * 128 + part * 8; bf16* k = q + 2048;
                h8_finish<128, 0, true>(aq[hb], q, Gq, C0, c.lane);
                h8_finish<128, 0, true>(ak[hb], k, Gk, C0, c.lane); }
            if (c.lane < 16) { const float z = bf2f(az) + bfv[c.lane];
                LOGF[(size_t)c.lane * S + t] = z >= 0.f ? -log1pf(__expf(-z)) : z - log1pf(__expf(z)); } }
#undef FOX_LOAD
    }
    SEAM(26);
    if (IN(27)) ph_cumsum(LOGF, (float*)(ws + WS_CUM), c);
    SEAM(27);
    if (IN(28)) { fa::AttnP A{P, P + 2048, P + 4096, Ob, 0.08838834764831845f * fa::LOG2E, nullptr, (const float*)(ws + WS_CUM), P + 6144, 0.f, 0.f, nullptr, nullptr}; fa::attn_phase<3, 128, fa::Strides<N_FOX_IN, 128, N_FOX_IN, 128, N_FOX_IN, 128, N_FOX_IN>>(A, c.lds, c.blk, c.G, c.wave); }
    SEAM(28);
    WOUT(3, 29, out)
    FFN_PHASES(3, 30)
#undef IN
#undef SEAM
#undef mod
#undef XB
#undef P
#undef Ob
#undef HID
#undef STAT
#undef BIAS
#undef BIASP
#undef xin
#undef out
#undef R64
#undef R32
#undef R16
#undef PM
#undef CN
#undef QRAW
#undef KVRAW
#undef Qb
#undef Kb
#undef IW
#undef SIDX
#undef MASK
#undef LOGF
}

extern "C" void kernel_launch(void* const* d_in, const int* in_sizes, int n_in, void* d_out, int out_size, void* d_ws, size_t ws_size, hipStream_t stream) {
    static int grid = 0;
    if (grid == 0) {
        if (n_in != N_IN || out_size != S * D || ws_size < WS_END) { fprintf(stderr, "kernel_launch: unexpected shapes: n_in %d out %d ws %zu (need %zu)\n", n_in, out_size, ws_size, (size_t)WS_END); grid = -1; return; }
        int dev = 0, cus = 0;
        if (hipGetDevice(&dev) != hipSuccess || hipDeviceGetAttribute(&cus, hipDeviceAttributeMultiprocessorCount, dev) != hipSuccess) { grid = -1; return; }
        if (hipFuncSetAttribute((const void*)mega, hipFuncAttributeMaxDynamicSharedMemorySize, LDS_BYTES) != hipSuccess) { fprintf(stderr, "kernel_launch: hipFuncSetAttribute failed\n"); grid = -1; return; }
        int per_cu = 0;
        if (hipOccupancyMaxActiveBlocksPerMultiprocessor(&per_cu, (const void*)mega, 512, LDS_BYTES) != hipSuccess || per_cu < 1) fprintf(stderr, "kernel_launch: occupancy query says %d\n", per_cu);
        (void)hipGetLastError();
        grid = cus;
    }
    if (grid < 0) return;
    (void)hipMemsetAsync((char*)d_ws + WS_CTL, 0, CTL_ZERO_BYTES, stream);
    Args a{};
    for (int i = 0; i < N_IN; ++i) a.in[i] = d_in[i];
    a.out = (float*)d_out; a.ws = (unsigned char*)d_ws;
#if MK_PER_PHASE
    for (int p = 0; p < NPHASE; ++p) { a.ph_lo = p; a.ph_hi = p + 1; hipLaunchKernelGGL(mega, dim3(grid), dim3(512), LDS_BYTES, stream, a); }
#else
    a.ph_lo = 0; a.ph_hi = NPHASE; hipLaunchKernelGGL(mega, dim3(grid), dim3(512), LDS_BYTES, stream, a);
#endif
}
```

```cpp
#include <hip/hip_runtime.h>
#include <cstdio>
#include <cstdint>

#ifndef REP_MASK
#define REP_MASK 0
#endif
#define LAS __attribute__((address_space(3)))
typedef unsigned short bf16;
typedef short bf16x8 __attribute__((ext_vector_type(8)));
typedef float f32x4 __attribute__((ext_vector_type(4)));
typedef float f32x2 __attribute__((ext_vector_type(2)));
typedef float f32x16 __attribute__((ext_vector_type(16)));
typedef unsigned u32x4 __attribute__((ext_vector_type(4)));
typedef unsigned u32x2 __attribute__((ext_vector_type(2)));
typedef unsigned long long u64;

constexpr int S = 8192, D = 2048, NH = 16, FF = 5632, NMOD = 6 * D;
constexpr float EPS = 1e-6f;
constexpr int N_MLA_IN = 1280, N_DSA_IN = 7424, N_DIFF_IN = 6144, N_FOX_IN = 8448;
enum { I_X = 0, I_C, I_POS, I_LN_MIX, I_LN_FFN, I_ADA_W, I_ADA_B, I_FFN_GU, I_FFN_DN,
       I_MLA_IN, I_MLA_QAG, I_MLA_KVAG, I_MLA_QB, I_MLA_KVB, I_MLA_QG, I_MLA_KG, I_MLA_OUT,
       I_DSA_IN, I_DSA_QG, I_DSA_KG, I_DSA_IKG, I_DSA_OUT,
       I_DIFF_IN, I_DIFF_QG, I_DIFF_KG, I_DIFF_LQ1, I_DIFF_LK1, I_DIFF_LQ2, I_DIFF_LK2, I_DIFF_SUBG, I_DIFF_OUT,
       I_FOX_IN, I_FOX_BF, I_FOX_QG, I_FOX_KG, I_FOX_OUT, N_IN };

constexpr size_t MiB = 1u << 20;
constexpr size_t WS_CTL = 0;
constexpr size_t WS_MODP = 1 * MiB;
constexpr size_t WS_MOD = 3 * MiB;
constexpr size_t WS_ROPE64 = 4 * MiB;
constexpr size_t WS_ROPE32 = 6 * MiB;
constexpr size_t WS_ROPE16 = 7 * MiB;
constexpr size_t WS_IW = 8 * MiB;
constexpr size_t WS_LOGF = 9 * MiB;
constexpr size_t WS_CUM = 10 * MiB;
constexpr size_t WS_W_MLA_IN = 16 * MiB;
constexpr size_t WS_W_MLA_QB = 21 * MiB;
constexpr size_t WS_W_MLA_KVB = 24 * MiB;
constexpr size_t WS_W_DSA_IN = 28 * MiB;
constexpr size_t WS_W_DIFF_IN = 57 * MiB;
constexpr size_t WS_W_FOX_IN = 81 * MiB;
constexpr size_t WS_W_OUT = 114 * MiB;
constexpr size_t WS_W_GU = 146 * MiB;
constexpr size_t WS_W_DN = 322 * MiB;
constexpr size_t WS_XB = 410 * MiB;
constexpr size_t WS_P = 442 * MiB;
constexpr size_t WS_PM = 574 * MiB;
constexpr size_t WS_CN = 594 * MiB;
constexpr size_t WS_Q = 610 * MiB;
constexpr size_t WS_K = 658 * MiB;
constexpr size_t WS_O = 706 * MiB;
constexpr size_t WS_HID = 738 * MiB;
constexpr size_t WS_MASK = 826 * MiB;
constexpr size_t WS_SIDX = 834 * MiB;
constexpr size_t WS_O1 = 1090 * MiB;
constexpr size_t WS_STAT = 11 * MiB;
constexpr size_t WS_GG = 12 * MiB;
constexpr size_t WS_BIAS = 13 * MiB;
constexpr size_t WS_BIASP = 1154 * MiB;
constexpr size_t WS_XL = 1170 * MiB;
constexpr size_t WS_END = 1202 * MiB;
constexpr size_t CTL_ZERO_BYTES = 1 * MiB;
constexpr int CW_BAR = 4096;

constexpr int LDS_BYTES = 147456;
constexpr int MISC_OFF = LDS_BYTES - 128;

__device__ __forceinline__ unsigned f2bf(float f) { unsigned u = __builtin_bit_cast(unsigned, f); return (u + 0x7fffu + ((u >> 16) & 1u)) >> 16; }
__device__ __forceinline__ unsigned pk2(float lo, float hi) { return f2bf(lo) | (f2bf(hi) << 16); }
__device__ __forceinline__ float bf2f(unsigned b) { return __builtin_bit_cast(float, b << 16); }
__device__ __forceinline__ float wave_sum(float v) {
#pragma unroll
    for (int o = 32; o >= 1; o >>= 1) v += __shfl_xor(v, o);
    return v;
}
__device__ __forceinline__ float wave_max(float v) {
#pragma unroll
    for (int o = 32; o >= 1; o >>= 1) v = fmaxf(v, __shfl_xor(v, o));
    return v;
}

#define XB_TMO      128
#define XB_XCNT(j)  (256  + 64 * (j))
#define XB_XSUB(j)  (1280 + 64 * (j))
#define XB_XGEN(j)  (2304 + 64 * (j))
#define XB_TOP      3328
#define XB_TOPGEN   3392
#define XCD_BAR_WORDS 3456
#define XB_SPIN_CAP (1u << 22)
__device__ __forceinline__ unsigned xb_ld(unsigned* p)              { return __hip_atomic_load(p, __ATOMIC_RELAXED, __HIP_MEMORY_SCOPE_AGENT); }
__device__ __forceinline__ unsigned xb_add(unsigned* p, unsigned v) { return __hip_atomic_fetch_add(p, v, __ATOMIC_RELAXED, __HIP_MEMORY_SCOPE_AGENT); }
__device__ __forceinline__ unsigned xb_xcc_id() { return (unsigned)__builtin_amdgcn_s_getreg((3 << 11) | 20) & 0xFu; }
#define XB_SPIN(cond, bar) do { unsigned _sp = 0; while (cond) { __builtin_amdgcn_s_sleep(1); \
    if ((++_sp & 255u) == 0u) { if (xb_ld(&(bar)[XB_TMO])) break; if (_sp > XB_SPIN_CAP) { atomicAdd(&(bar)[XB_TMO], 1u); break; } } } } while (0)
__device__ __forceinline__ int tid_of(int wave) { int l; asm volatile("v_mbcnt_lo_u32_b32 %0, -1, 0\n\tv_mbcnt_hi_u32_b32 %0, -1, %0" : "=v"(l)); return wave * 64 + l; }
struct XcdBarrier { unsigned* bar; unsigned x; volatile LAS unsigned* st; int wave; };
__device__ __forceinline__ XcdBarrier xcd_barrier_post(unsigned* bar, volatile LAS unsigned* st, int wave) {
    XcdBarrier b; b.bar = bar; b.x = xb_xcc_id(); b.st = st; b.wave = wave;
    if (tid_of(wave) == 0) (void)xb_add(&bar[XB_XCNT(b.x)], 1u);
    return b;
}
__device__ __forceinline__ void xcd_barrier_complete(unsigned* bar, unsigned x, unsigned& nloc, unsigned& nx) {
    const unsigned G = gridDim.x * gridDim.y * gridDim.z;
    unsigned sum, cnt, mine, sp = 0u;
    for (;;) {
        sum = 0u; cnt = 0u; mine = 0u;
#pragma unroll
        for (unsigned j = 0; j < 16; ++j) { const unsigned c = xb_ld(&bar[XB_XCNT(j)]); sum += c; cnt += (c > 0u) ? 1u : 0u; mine = (j == x) ? c : mine; }
        if (sum == G) break;
        __builtin_amdgcn_s_sleep(1);
        if ((++sp & 255u) == 0u) { if (xb_ld(&bar[XB_TMO])) break; if (sp > XB_SPIN_CAP) { atomicAdd(&bar[XB_TMO], 1u); break; } }
    }
    nloc = mine > 0u ? mine : 1u; nx = cnt > 0u ? cnt : 1u;
}
__device__ __forceinline__ void xcd_barrier(const XcdBarrier& b) {
    asm volatile("s_waitcnt vmcnt(0)" ::: "memory");
    __syncthreads();
    if (tid_of(b.wave) == 0) {
        unsigned* bar = b.bar;
        __builtin_amdgcn_s_waitcnt(0);
        unsigned nloc = b.st[0], nx = b.st[1];
        if (nloc == 0u) { xcd_barrier_complete(bar, b.x, nloc, nx); b.st[0] = nloc; b.st[1] = nx; }
        const unsigned old = xb_add(&bar[XB_XSUB(b.x)], 1u);
        const unsigned gen = old / nloc;
        if (old + 1u == (gen + 1u) * nloc) {
            __builtin_amdgcn_fence(__ATOMIC_RELEASE, "agent");
            asm volatile("s_waitcnt vmcnt(0)" ::: "memory");
            const unsigned og = xb_add(&bar[XB_TOP], 1u);
            const unsigned tg = og / nx;
            if (og + 1u == (tg + 1u) * nx) xb_add(&bar[XB_TOPGEN], 1u);
            else XB_SPIN(xb_ld(&bar[XB_TOPGEN]) == tg, bar);
            __builtin_amdgcn_fence(__ATOMIC_ACQUIRE, "agent");
            xb_add(&bar[XB_XGEN(b.x)], 1u);
            asm volatile("s_waitcnt vmcnt(0)" ::: "memory");
        } else {
            XB_SPIN(xb_ld(&bar[XB_XGEN(b.x)]) == gen, bar);
            __builtin_amdgcn_fence(__ATOMIC_ACQUIRE, "agent");
            asm volatile("s_waitcnt vmcnt(0)" ::: "memory");
        }
    }
    __syncthreads();
}

struct Args { const void* in[N_IN]; float* out; unsigned char* ws; int ph_lo, ph_hi; };

struct Ctx { LAS unsigned char* lds; int tid, lane, wave, gw, ngw, G, blk; };
#define GAS __attribute__((address_space(1)))
__device__ __forceinline__ unsigned char* launder_ptr(unsigned char* p) { GAS unsigned char* g = (GAS unsigned char*)p; asm volatile("" : "+s"(g)); return (unsigned char*)g; }
__device__ __forceinline__ void fresh(Ctx& c) { int l; asm volatile("v_mbcnt_lo_u32_b32 %0, -1, 0\n\tv_mbcnt_hi_u32_b32 %0, -1, %0" : "=v"(l)); c.lane = l; c.tid = c.wave * 64 + l; }


constexpr int BO_MLA = 0, BO_DSA = BO_MLA + N_MLA_IN, BO_DIFF = BO_DSA + N_DSA_IN, BO_FOX = BO_DIFF + N_DIFF_IN, BO_GU = BO_FOX + N_FOX_IN, NBIAS = BO_GU + 4 * 2 * FF;
static_assert(NBIAS == 68352, "bias columns");

__device__ __forceinline__ int srccol(int kind, int n, int nsrc) {
    if (kind == 0) return n < nsrc ? n : -1;
    if (kind == 1) { const int t = n >> 8, w = n & 255; return w < 128 ? t * 128 + w : FF + t * 128 + (w - 128); }
    if (n < 6144) return n; if (n < 8192) return n + 16; if (n < 8208) return 6144 + (n - 8192); return -1;
}
__device__ __forceinline__ void transpose_item(const float* W, int K, int nsrc, bf16* WT, int kind, int k0, int n0, const float* gg, const float* sh, float* biasp, int lane) {
    const int n4 = lane & 7, kb = lane >> 3, n = n0 + 4 * n4, col = srccol(kind, n, nsrc);
    f32x4 v[8];
    const float* src = W + (size_t)(k0 + 8 * kb) * nsrc + (col >= 0 ? col : 0);
#pragma unroll
    for (int i = 0; i < 8; ++i) v[i] = *(const f32x4*)(src + (size_t)i * nsrc);
    const float msk = col >= 0 ? 1.f : 0.f;
    float sc[8];
#pragma unroll
    for (int i = 0; i < 8; ++i) sc[i] = msk;
    if (gg) { const f32x4 g0 = *(const f32x4*)(gg + k0 + 8 * kb), g1 = *(const f32x4*)(gg + k0 + 8 * kb + 4), s0 = *(const f32x4*)(sh + k0 + 8 * kb), s1 = *(const f32x4*)(sh + k0 + 8 * kb + 4);
        float b[4];
#pragma unroll
        for (int j = 0; j < 4; ++j) { b[j] = (s0[0] * v[0][j] + s0[1] * v[1][j] + s0[2] * v[2][j] + s0[3] * v[3][j] + s1[0] * v[4][j] + s1[1] * v[5][j] + s1[2] * v[6][j] + s1[3] * v[7][j]) * msk;
            b[j] += __shfl_xor(b[j], 8); b[j] += __shfl_xor(b[j], 16); b[j] += __shfl_xor(b[j], 32); }
        if (kb == 0) *(f32x4*)(biasp + n) = (f32x4){b[0], b[1], b[2], b[3]};
#pragma unroll
        for (int i = 0; i < 4; ++i) { sc[i] *= g0[i]; sc[4 + i] *= g1[i]; } }
    bf16* dst = WT + (size_t)n * K + k0 + 8 * kb;
#pragma unroll
    for (int j = 0; j < 4; ++j) { u32x4 o; o.x = pk2(v[0][j] * sc[0], v[1][j] * sc[1]); o.y = pk2(v[2][j] * sc[2], v[3][j] * sc[3]); o.z = pk2(v[4][j] * sc[4], v[5][j] * sc[5]); o.w = pk2(v[6][j] * sc[6], v[7][j] * sc[7]);
        *(u32x4*)(dst + (size_t)j * K) = o; }
}
struct WDesc { int in_idx; int layer; int K, nsrc, npad, kind; size_t dst; int norm  , bo; };
__device__ __forceinline__ WDesc wdesc(int m) {
    switch (m) {
    case 0: return {I_MLA_IN, 0, D, 1088, N_MLA_IN, 0, WS_W_MLA_IN, 0, BO_MLA};
    case 1: return {I_MLA_QB, 0, 512, 3072, 3072, 0, WS_W_MLA_QB, -1, 0};
    case 2: return {I_MLA_KVB, 0, 512, 4096, 4096, 0, WS_W_MLA_KVB, -1, 0};
    case 3: return {I_MLA_OUT, 0, D, D, D, 0, WS_W_OUT + 0 * 8 * MiB, -1, 0};
    case 4: return {I_DSA_IN, 0, D, 7248, N_DSA_IN, 0, WS_W_DSA_IN, 1, BO_DSA};
    case 5: return {I_DSA_OUT, 0, D, D, D, 0, WS_W_OUT + 1 * 8 * MiB, -1, 0};
    case 6: return {I_DIFF_IN, 0, D, 6144, N_DIFF_IN, 0, WS_W_DIFF_IN, 2, BO_DIFF};
    case 7: return {I_DIFF_OUT, 0, D, D, D, 0, WS_W_OUT + 2 * 8 * MiB, -1, 0};
    case 8: return {I_FOX_IN, 0, D, 8208, N_FOX_IN, 2, WS_W_FOX_IN, 3, BO_FOX};
    case 9: return {I_FOX_OUT, 0, D, D, D, 0, WS_W_OUT + 3 * 8 * MiB, -1, 0};
    case 10: case 11: case 12: case 13: return {I_FFN_GU, m - 10, D, 2 * FF, 2 * FF, 1, WS_W_GU + (size_t)(m - 10) * 44 * MiB, 4 + (m - 10), BO_GU + (m - 10) * 2 * FF};
    default: return {I_FFN_DN, m - 14, FF, D, D, 0, WS_W_DN + (size_t)(m - 14) * 22 * MiB, -1, 0};
    }
}
__device__ __forceinline__ void ph_phase0(const Args& a, const Ctx& c) {
    LAS float* cond = (LAS float*)c.lds;
    const float* cin = (const float*)a.in[I_C];
    for (int i = c.tid; i < D; i += 512) { const float v = cin[i]; cond[i] = v / (1.f + __expf(-v)); }
    __syncthreads();
    {
        const float* W = (const float*)a.in[I_ADA_W]; float* modp = (float*)(a.ws + WS_MODP);
        for (int task = c.gw; task < 4 * 48 * 8; task += c.ngw) {
            const int ks = task & 7, cg = (task >> 3) % 48, l = task / (8 * 48);
            const float* wp = W + ((size_t)l * D + ks * 256) * NMOD + cg * 256 + c.lane * 4;
            f32x4 acc = {0.f, 0.f, 0.f, 0.f};
#pragma unroll 8
            for (int k = 0; k < 256; ++k) { const f32x4 w = *(const f32x4*)(wp + (size_t)k * NMOD); acc += w * cond[ks * 256 + k]; }
            *(f32x4*)(modp + ((size_t)(ks * 4 + l)) * NMOD + cg * 256 + c.lane * 4) = acc;
        }
    }
    {
        const int* pos = (const int*)a.in[I_POS];
        f32x2* r64 = (f32x2*)(a.ws + WS_ROPE64); f32x2* r32 = (f32x2*)(a.ws + WS_ROPE32); f32x2* r16 = (f32x2*)(a.ws + WS_ROPE16);
        const int gt = c.blk * 512 + c.tid, ngt = c.G * 512;
        for (int i = gt; i < S * 56; i += ngt) {
            const int t = i / 56, j = i % 56; int rot, fi; f32x2* dst;
            if (j < 32) { rot = 64; fi = j; dst = r64 + t * 32 + fi; } else if (j < 48) { rot = 32; fi = j - 32; dst = r32 + t * 16 + fi; } else { rot = 16; fi = j - 48; dst = r16 + t * 8 + fi; }
            const float invf = (float)exp2(-(double)(2 * fi) / (double)rot * 18.931568569324174);
            const float ang = (float)pos[t] * invf;
            double rev = (double)ang * 0.15915494309189535; rev -= rint(rev);
            const float rv = (float)rev;
            *dst = (f32x2){__builtin_amdgcn_cosf(rv), __builtin_amdgcn_sinf(rv)};
        }
    }
    {
        const float* x = (const float*)a.in[I_X]; bf16* xb = (bf16*)(a.ws + WS_XB); bf16* xl = (bf16*)(a.ws + WS_XL); float* stat = (float*)(a.ws + WS_STAT);
        f32x4 nx[8];
        { const f32x4* xr = (const f32x4*)(x + (size_t)(c.gw < S ? c.gw : 0) * D) + c.lane;
#pragma unroll
          for (int j = 0; j < 8; ++j) nx[j] = xr[64 * j]; }
        for (int r = c.gw; r < S; r += c.ngw) {
            u32x2* o = (u32x2*)(xb + (size_t)r * D) + c.lane; u32x2* ol = (u32x2*)(xl + (size_t)r * D) + c.lane; float ss = 0.f;
            f32x4 cx[8];
#pragma unroll
            for (int j = 0; j < 8; ++j) cx[j] = nx[j];
            { const int rn = r + c.ngw < S ? r + c.ngw : r; const f32x4* xr = (const f32x4*)(x + (size_t)rn * D) + c.lane;
#pragma unroll
              for (int j = 0; j < 8; ++j) nx[j] = xr[64 * j]; }
#pragma unroll
            for (int j = 0; j < 8; ++j) { const f32x4 v = cx[j]; ss += v.x * v.x + v.y * v.y + v.z * v.z + v.w * v.w; const unsigned h0 = pk2(v.x, v.y), h1 = pk2(v.z, v.w);
                o[64 * j] = (u32x2){h0, h1}; ol[64 * j] = (u32x2){pk2(v.x - bf2f(h0 & 0xffffu), v.y - bf2f(h0 >> 16)), pk2(v.z - bf2f(h1 & 0xffffu), v.w - bf2f(h1 >> 16))}; }
            ss = wave_sum(ss);
            if (c.lane < 8) stat[r * 8 + c.lane] = c.lane == 0 ? ss : 0.f;
        }
    }
}
__device__ __forceinline__ void ph_modfinal(const Args& a, const Ctx& c) {
    const float* modp = (const float*)(a.ws + WS_MODP); const float* b = (const float*)a.in[I_ADA_B]; float* mod = (float*)(a.ws + WS_MOD); float* gg = (float*)(a.ws + WS_GG);
    for (int i = c.blk * 512 + c.tid; i < 4 * NMOD; i += c.G * 512) {
        const int l = i / NMOD, col = i % NMOD; float s = b[i];
#pragma unroll
        for (int ks = 0; ks < 8; ++ks) s += modp[(size_t)(ks * 4 + l) * NMOD + col];
        mod[i] = s;
        const int seg = col / D, k = col % D;
        if (seg == 1) gg[l * D + k] = ((const float*)a.in[I_LN_MIX])[l * D + k] * (1.f + s);
        if (seg == 4) gg[(4 + l) * D + k] = ((const float*)a.in[I_LN_FFN])[l * D + k] * (1.f + s);
    }
}
__device__ __forceinline__ void ph_weights(const Args& a, const Ctx& c) {
    const float* mod = (const float*)(a.ws + WS_MOD); const float* gga = (const float*)(a.ws + WS_GG); float* biasp = (float*)(a.ws + WS_BIASP);
    for (int m = 0; m < 18; ++m) {
        const WDesc d = wdesc(m);
        const float* W = (const float*)a.in[d.in_idx] + (size_t)d.layer * d.K * d.nsrc;
        bf16* WT = (bf16*)(a.ws + d.dst);
        const float* gg = d.norm >= 0 ? gga + d.norm * D : nullptr;
        const float* sh = d.norm >= 0 ? mod + (d.norm & 3) * NMOD + (d.norm >= 4 ? 3 * D : 0) : nullptr;
        const int nblk = d.npad / 32, nitems = (d.K / 64) * nblk;
        for (int it = c.gw; it < nitems; it += c.ngw) { const int kt = it / nblk, n0 = 32 * (it % nblk);
            transpose_item(W, d.K, d.nsrc, WT, d.kind, 64 * kt, n0, gg, sh, biasp + (size_t)kt * NBIAS + d.bo, c.lane); }
    }
}
namespace pg8 {
constexpr int BM = 256, BK = 64, HALF = 128, HTB = HALF * BK * 2, STAGE_BYTES = 8 * HTB, NXCD = 8, WGM = 8;
__host__ __device__ __forceinline__ int lds_byte(int r, int c) { const int st = (r >> 4) * 2 + (c >> 5), rr = r & 15, cc = c & 31, ob = rr * 64 + cc * 2; return st * 1024 + (ob ^ (((ob >> 9) & 1) << 5)); }
__host__ __device__ __forceinline__ void stage_rc(int b, int& R, int& C) { const int st = b / 1024, sb = b % 1024, swz = sb ^ (((sb >> 9) & 1) << 5); R = (st >> 1) * 16 + swz / 64; C = (st & 1) * 32 + (swz % 64) / 2; }
__host__ __device__ __forceinline__ int perm32(int rho) { const int n = rho >> 4, i = rho & 15; return 8 * (i >> 2) + 4 * n + (i & 3); }
struct Unit { int pm, pn, hsel; };
struct Gemm { const bf16* A; int lda; const bf16* Bt; int ldb; int M, N, K; };
struct StaticOrder {
    int nM, nN, nwg, G, c, nhalf;
    __device__ void init(int M, int N, int G_, int c_, int nht = 0) { nM = M / BM; nN = N / BM - nht; nwg = nM * nN; G = G_; c = c_; nhalf = 2 * nM * nht; }
    __device__ bool next(int i, Unit& u) const {
        const long L = (long)i * G + c; if (L >= nwg + nhalf) return false;
        const bool isH = L >= nwg; const int h = (int)L - nwg;
        int wgid = isH ? 0 : (int)L; { const int q = nwg / NXCD, r = nwg % NXCD, xcd = wgid % NXCD, off = wgid / NXCD; wgid = (xcd < r ? xcd * (q + 1) : r * (q + 1) + (xcd - r) * q) + off; }
        const int nig = WGM * nN, gid = wgid / nig, fm = gid * WGM, gsz = (nM - fm) < WGM ? (nM - fm) : WGM;
        const int fpm = fm + ((wgid % nig) % gsz), fpn = (wgid % nig) / gsz;
        u.pm = isH ? (h >> 1) % nM : fpm; u.pn = isH ? nN + (h >> 1) / nM : fpn; u.hsel = isH ? (h & 1) : -1; return true;
    }
};
__device__ __forceinline__ unsigned cvt_pk_bf16(float lo, float hi) { unsigned r; asm volatile("v_cvt_pk_bf16_f32 %0, %1, %2" : "=v"(r) : "v"(lo), "v"(hi)); return r; }
__device__ __forceinline__ float row_rstd(const float* stat, int row) { const f32x4 a = *(const f32x4*)(stat + row * 8), b = *(const f32x4*)(stat + row * 8 + 4);
    return rsqrtf(((a.x + a.y) + (a.z + a.w) + (b.x + b.y) + (b.z + b.w)) * (1.f / D) + EPS); }
struct EpiStoreP { bf16* O; int ldc; const float* stat; const float* bias;
    __device__ __forceinline__ void operator()(const f32x4 (&acc)[2][2][4][2], const Unit& u, int wr, int wc, int fr, int fq, LAS unsigned char*) const {
        const int row0 = u.pm * BM + (u.hsel > 0 ? HALF : 0) + wr * 64 + fr, col0 = u.pn * BM + wc * 32 + 8 * fq; const int nai = u.hsel >= 0 ? 1 : 2;
        f32x4 bv[2][2];
#pragma unroll
        for (int bj = 0; bj < 2; ++bj)
#pragma unroll
            for (int n = 0; n < 2; ++n) bv[bj][n] = stat ? *(const f32x4*)(bias + col0 + bj * HALF + 4 * n) : (f32x4){0.f, 0.f, 0.f, 0.f};
        float rsv[2][4];
#pragma unroll
        for (int ai = 0; ai < 2; ++ai) if (ai < nai)
#pragma unroll
            for (int m = 0; m < 4; ++m) rsv[ai][m] = stat ? row_rstd(stat, row0 + ai * HALF + m * 16) : 1.f;
#pragma unroll
        for (int ai = 0; ai < 2; ++ai) if (ai < nai)
#pragma unroll
            for (int m = 0; m < 4; ++m) { const int row = row0 + ai * HALF + m * 16; bf16* rowp = O + (size_t)row * ldc + col0;
                const float rs = rsv[ai][m];
#pragma unroll
                for (int bj = 0; bj < 2; ++bj) { const f32x4 v0 = acc[ai][bj][m][0] * rs + bv[bj][0], v1 = acc[ai][bj][m][1] * rs + bv[bj][1];
                    u32x4 w; w.x = cvt_pk_bf16(v0[0], v0[1]); w.y = cvt_pk_bf16(v0[2], v0[3]); w.z = cvt_pk_bf16(v1[0], v1[1]); w.w = cvt_pk_bf16(v1[2], v1[3]);
                    *(u32x4*)(rowp + bj * HALF) = w; } }
    } };
template <bool LAST>
struct EpiResP { bf16* xb; bf16* xl; const float* g; float* stat; float* fout;
    __device__ __forceinline__ void operator()(const f32x4 (&acc)[2][2][4][2], const Unit& u, int wr, int wc, int fr, int fq, LAS unsigned char* lds) const {
        const int col0 = u.pn * BM + wc * 32 + 8 * fq;
        LAS float* part = (LAS float*)(lds + 132096);
        f32x4 gv[2][2];
#pragma unroll
        for (int bj = 0; bj < 2; ++bj)
#pragma unroll
            for (int n = 0; n < 2; ++n) gv[bj][n] = *(const f32x4*)(g + col0 + bj * HALF + 4 * n);
#pragma unroll
        for (int ai = 0; ai < 2; ++ai) {
            u32x4 hv[4][2], lv[4][2];
#pragma unroll
            for (int m = 0; m < 4; ++m) { const size_t o = (size_t)(u.pm * BM + wr * 64 + fr + ai * HALF + m * 16) * D + col0;
#pragma unroll
                for (int bj = 0; bj < 2; ++bj) { hv[m][bj] = *(const u32x4*)(xb + o + bj * HALF); lv[m][bj] = *(const u32x4*)(xl + o + bj * HALF); } }
#pragma unroll
            for (int m = 0; m < 4; ++m) { const int rl = wr * 64 + fr + ai * HALF + m * 16; const size_t o = (size_t)(u.pm * BM + rl) * D + col0; float ss = 0.f;
#pragma unroll
                for (int bj = 0; bj < 2; ++bj) { const size_t oo = o + bj * HALF; float xn[8];
#pragma unroll
                    for (int e = 0; e < 4; ++e) { const unsigned hw = hv[m][bj][e], lw = lv[m][bj][e];
                        xn[2 * e] = (bf2f(hw & 0xffffu) + bf2f(lw & 0xffffu)) + gv[bj][e >> 1][(2 * e) & 3] * acc[ai][bj][m][e >> 1][(2 * e) & 3];
                        xn[2 * e + 1] = (bf2f(hw >> 16) + bf2f(lw >> 16)) + gv[bj][e >> 1][(2 * e + 1) & 3] * acc[ai][bj][m][e >> 1][(2 * e + 1) & 3]; }
                    ss += (xn[0] * xn[0] + xn[1] * xn[1]) + (xn[2] * xn[2] + xn[3] * xn[3]) + (xn[4] * xn[4] + xn[5] * xn[5]) + (xn[6] * xn[6] + xn[7] * xn[7]);
                    if constexpr (LAST) { *(f32x4*)(fout + oo) = (f32x4){xn[0], xn[1], xn[2], xn[3]}; *(f32x4*)(fout + oo + 4) = (f32x4){xn[4], xn[5], xn[6], xn[7]}; }
                    else { u32x4 w, wl;
#pragma unroll
                        for (int e = 0; e < 4; ++e) { w[e] = cvt_pk_bf16(xn[2 * e], xn[2 * e + 1]); wl[e] = cvt_pk_bf16(xn[2 * e] - bf2f(w[e] & 0xffffu), xn[2 * e + 1] - bf2f(w[e] >> 16)); }
                        *(u32x4*)(xb + oo) = w; *(u32x4*)(xl + oo) = wl; } }
                ss += __shfl_xor(ss, 16); ss += __shfl_xor(ss, 32);
                if (fq == 0) part[rl * 4 + wc] = ss; } }
        asm volatile("s_waitcnt lgkmcnt(0)" ::: "memory"); __builtin_amdgcn_s_barrier();
        const int tid = (wr * 4 + wc) * 64 + fq * 16 + fr;
        if (tid < 256) { const f32x4 p = *(const LAS f32x4*)(part + tid * 4); stat[(size_t)(u.pm * BM + tid) * 8 + u.pn] = (p.x + p.y) + (p.z + p.w); }
    } };
struct EpiSwigluP { bf16* Hd; const float* stat; const float* bias;
    __device__ __forceinline__ void operator()(const f32x4 (&acc)[2][2][4][2], const Unit& u, int wr, int wc, int fr, int fq, LAS unsigned char*) const {
        const int row0 = u.pm * BM + (u.hsel > 0 ? HALF : 0) + wr * 64 + fr, hc0 = u.pn * HALF + wc * 32 + 8 * fq, col0 = u.pn * BM + wc * 32 + 8 * fq; const int nai = u.hsel >= 0 ? 1 : 2;
        f32x4 bv[2][2];
#pragma unroll
        for (int bj = 0; bj < 2; ++bj)
#pragma unroll
            for (int n = 0; n < 2; ++n) bv[bj][n] = *(const f32x4*)(bias + col0 + bj * HALF + 4 * n);
        float rsv[2][4];
#pragma unroll
        for (int ai = 0; ai < 2; ++ai) if (ai < nai)
#pragma unroll
            for (int m = 0; m < 4; ++m) rsv[ai][m] = row_rstd(stat, row0 + ai * HALF + m * 16);
#pragma unroll
        for (int ai = 0; ai < 2; ++ai) if (ai < nai)
#pragma unroll
            for (int m = 0; m < 4; ++m) { const int row = row0 + ai * HALF + m * 16; const float rs = rsv[ai][m]; float r[8];
#pragma unroll
                for (int n = 0; n < 2; ++n)
#pragma unroll
                    for (int i = 0; i < 4; ++i) { const float gt = acc[ai][0][m][n][i] * rs + bv[0][n][i], up = acc[ai][1][m][n][i] * rs + bv[1][n][i]; r[4 * n + i] = gt * __builtin_amdgcn_rcpf(1.f + __expf(-gt)) * up; }
                u32x4 w; w.x = cvt_pk_bf16(r[0], r[1]); w.y = cvt_pk_bf16(r[2], r[3]); w.z = cvt_pk_bf16(r[4], r[5]); w.w = cvt_pk_bf16(r[6], r[7]);
                *(u32x4*)(Hd + (size_t)row * FF + hc0) = w; }
    } };

template <class Epi>
__device__ __forceinline__ void gemm_phase(LAS unsigned char* lds, const Gemm g, const StaticOrder& S, const Epi& E, const int wave) {
    const int tid = tid_of(wave), wid = wave, lane = tid & 63, wr = wid >> 2, wc = wid & 3, fr = lane & 15, fq = lane >> 4;
    const int K = g.K, nt = K / BK;
    unsigned voffA[2], voffB[2];
#pragma unroll
    for (int i = 0; i < 2; ++i) { int R, C; stage_rc(tid * 16 + i * 8192, R, C); const int Rb = (R & ~31) + perm32(R & 31);
        voffA[i] = (unsigned)(R * g.lda + C) * 2u; voffB[i] = (unsigned)(Rb * g.ldb + C) * 2u; }
    const size_t kstep = (size_t)(BK * 2);
    const size_t hstepA = (size_t)HALF * g.lda * 2, hstepB = (size_t)HALF * g.ldb * 2;
    const size_t tstepA = 2 * hstepA, tstepB = 2 * hstepB;
    const unsigned ldsw = (unsigned)wid * 1024u;
    const int aoff = lds_byte(wr * 64 + fr, fq * 8), boff = lds_byte(wc * 32 + fr, fq * 8);
#define PG8_SA(b, h) (((b) * 2 + (h)) * HTB)
#define PG8_SB(b, h) ((4 + (b) * 2 + (h)) * HTB)
#define PG8_STAGE(bufoff, gbase, voff) do { _Pragma("unroll") for (int _i = 0; _i < 2; ++_i) \
        __builtin_amdgcn_global_load_lds((const unsigned*)((const char*)(gbase) + (voff)[_i]), (LAS unsigned*)(lds + (bufoff) + ldsw + _i * 8192), 16, 0, 0); } while (0)
#define PG8_LDA(dst, b, h) do { _Pragma("unroll") for (int m = 0; m < 4; ++m) _Pragma("unroll") for (int k = 0; k < 2; ++k) dst[m][k] = *(const LAS bf16x8*)(lds + PG8_SA(b, h) + aoff + m * 2048 + k * 1024); } while (0)
#define PG8_LDB(dst, b, h) do { _Pragma("unroll") for (int n = 0; n < 2; ++n) _Pragma("unroll") for (int k = 0; k < 2; ++k) dst[n][k] = *(const LAS bf16x8*)(lds + PG8_SB(b, h) + boff + n * 2048 + k * 1024); } while (0)
#define PG8_MMA(ai, bj, At, Bt) do { __builtin_amdgcn_s_setprio(1); _Pragma("unroll") for (int m = 0; m < 4; ++m) _Pragma("unroll") for (int n = 0; n < 2; ++n) _Pragma("unroll") for (int k = 0; k < 2; ++k) \
        acc[ai][bj][m][n] = __builtin_amdgcn_mfma_f32_16x16x32_bf16(Bt[n][k], At[m][k], acc[ai][bj][m][n], 0, 0, 0); __builtin_amdgcn_s_setprio(0); } while (0)
#define PG8_WAIT_V(n) asm volatile("s_waitcnt vmcnt(" #n ")" ::: "memory")
#define PG8_WAIT_L(n) asm volatile("s_waitcnt lgkmcnt(" #n ")" ::: "memory")
#define PG8_BAR __builtin_amdgcn_s_barrier()
#define PG8_SCHED __builtin_amdgcn_sched_barrier(0)
    Unit cur, nxt; int ui = 0;
    if (!S.next(0, cur)) return;
    f32x4 acc[2][2][4][2];
#pragma unroll
    for (int a = 0; a < 2; ++a)
#pragma unroll
        for (int b = 0; b < 2; ++b)
#pragma unroll
            for (int m = 0; m < 4; ++m)
#pragma unroll
                for (int n = 0; n < 2; ++n) acc[a][b][m][n] = (f32x4){0.f, 0.f, 0.f, 0.f};
    bf16x8 At[4][2], B0[2][2], B1[2][2];
    const char* cA = (const char*)g.A + (size_t)cur.pm * tstepA + (cur.hsel > 0 ? hstepA : 0); const char* cB = (const char*)g.Bt + (size_t)cur.pn * tstepB;
    PG8_STAGE(PG8_SB(0, 0), cB, voffB); PG8_STAGE(PG8_SB(0, 1), cB + hstepB, voffB); PG8_STAGE(PG8_SA(0, 0), cA, voffA); PG8_STAGE(PG8_SA(0, 1), cA + hstepA, voffA);
    if (wr == 1) PG8_BAR;
    PG8_WAIT_V(2); PG8_BAR;
    PG8_STAGE(PG8_SB(1, 0), cB + kstep, voffB); PG8_STAGE(PG8_SA(1, 0), cA + kstep, voffA); PG8_STAGE(PG8_SB(1, 1), cB + hstepB + kstep, voffB);
    PG8_WAIT_V(6); PG8_BAR;
    for (;;) {
        const bool has_next = S.next(ui + 1, nxt);
        const char* nA = has_next ? (const char*)g.A + (size_t)nxt.pm * tstepA + (nxt.hsel > 0 ? hstepA : 0) : cA; const char* nB = has_next ? (const char*)g.Bt + (size_t)nxt.pn * tstepB : cB;
        const bool full = cur.hsel < 0;
        for (int t = 0; t < nt; t += 2) {
            const bool last = (t == nt - 2);
            const char* a1 = cA + (size_t)(t + 1) * kstep;
            const char* a2 = last ? nA : cA + (size_t)(t + 2) * kstep; const char* b2 = last ? nB : cB + (size_t)(t + 2) * kstep;
            const char* a3 = a2 + kstep; const char* b3 = b2 + kstep;
            PG8_LDB(B0, 0, 0); PG8_LDB(B1, 0, 1); PG8_SCHED; PG8_LDA(At, 0, 0); PG8_STAGE(PG8_SA(1, 1), a1 + hstepA, voffA);
            PG8_WAIT_V(8); PG8_WAIT_L(0); PG8_BAR; PG8_MMA(0, 0, At, B0); PG8_MMA(0, 1, At, B1); PG8_BAR; PG8_SCHED;
            PG8_LDA(At, 0, 1); PG8_STAGE(PG8_SB(0, 0), b2, voffB); PG8_STAGE(PG8_SB(0, 1), b2 + hstepB, voffB); PG8_STAGE(PG8_SA(0, 0), a2, voffA);
            PG8_WAIT_V(8); PG8_WAIT_L(0); PG8_BAR; if (full) { PG8_MMA(1, 0, At, B0); PG8_MMA(1, 1, At, B1); } PG8_BAR; PG8_SCHED;
            PG8_LDB(B0, 1, 0); PG8_LDB(B1, 1, 1); PG8_SCHED; PG8_LDA(At, 1, 0); PG8_STAGE(PG8_SA(0, 1), a2 + hstepA, voffA);
            PG8_WAIT_V(8); PG8_WAIT_L(0); PG8_BAR; PG8_MMA(0, 0, At, B0); PG8_MMA(0, 1, At, B1); PG8_BAR; PG8_SCHED;
            PG8_LDA(At, 1, 1); PG8_STAGE(PG8_SB(1, 0), b3, voffB); PG8_STAGE(PG8_SB(1, 1), b3 + hstepB, voffB); PG8_STAGE(PG8_SA(1, 0), a3, voffA);
            PG8_WAIT_V(8); PG8_WAIT_L(0); PG8_BAR; if (full) { PG8_MMA(1, 0, At, B0); PG8_MMA(1, 1, At, B1); } PG8_BAR; PG8_SCHED;
        }
        if (wr == 0) PG8_BAR;
        E(acc, cur, wr, wc, fr, fq, lds);
        if (!has_next) break;
#pragma unroll
        for (int a = 0; a < 2; ++a)
#pragma unroll
            for (int b = 0; b < 2; ++b)
#pragma unroll
                for (int m = 0; m < 4; ++m)
#pragma unroll
                    for (int n = 0; n < 2; ++n) acc[a][b][m][n] = (f32x4){0.f, 0.f, 0.f, 0.f};
        cur = nxt; cA = nA; cB = nB; ++ui;
        if (wr == 1) PG8_BAR;
    }
    PG8_WAIT_V(0);
    PG8_BAR;
#undef PG8_SA
#undef PG8_SB
#undef PG8_STAGE
#undef PG8_LDA
#undef PG8_LDB
#undef PG8_MMA
#undef PG8_WAIT_V
#undef PG8_WAIT_L
#undef PG8_BAR
#undef PG8_SCHED
}
}
__device__ __forceinline__ void bias_reduce(const float* biasp, float* bias, int M, int N, int G, int blk, int wave, int nht) {
    pg8::StaticOrder S_; S_.init(M, N, G, blk, nht); pg8::Unit u;
    const int tid = tid_of(wave);
    for (int i = 0; S_.next(i, u); ++i) if (tid < 256) { const int col = u.pn * 256 + tid; float s = 0.f;
#pragma unroll 8
        for (int kt = 0; kt < 32; ++kt) s += biasp[(size_t)kt * NBIAS + col];
        bias[col] = s; }
    asm volatile("s_waitcnt vmcnt(0)" ::: "memory"); __syncthreads();
}
__device__ __forceinline__ void bias_all(const float* biasp, float* bias, int c0, const Ctx& c) {
    for (int col = c0 + c.blk * 512 + c.tid; col < NBIAS; col += c.G * 512) { float s = 0.f;
#pragma unroll
        for (int kt = 0; kt < 32; ++kt) s += biasp[(size_t)kt * NBIAS + col];
        bias[col] = s; }
}
#define GEMM_SITE(EPI_P, Aptr, LDA, Bptr, LDB, MM, NN, KK, NHT) do { pg8::Gemm g_{Aptr, LDA, Bptr, LDB, MM, NN, KK}; pg8::StaticOrder S_; S_.init(MM, NN, c.G, c.blk, NHT); pg8::gemm_phase(c.lds, g_, S_, EPI_P, c.wave); } while (0)

template <int HD, int ROT, bool NORM>
__device__ __forceinline__ void heads8_norm_rope(const bf16* src0, const bf16* srcn, bf16* dst, const float* gain, const f32x2* rope, int lane) {
    constexpr int V = HD / 64; const int part = lane & 7;
    float x[V][8];
    { const u32x4 r = *(const u32x4*)src0;
#pragma unroll
      for (int e = 0; e < 4; ++e) { x[0][2 * e] = bf2f(r[e] & 0xffffu); x[0][2 * e + 1] = bf2f(r[e] >> 16); } }
#pragma unroll
    for (int v = 1; v < V; ++v) { const u32x4 r = *(const u32x4*)(srcn + 64 * (v - 1));
#pragma unroll
        for (int e = 0; e < 4; ++e) { x[v][2 * e] = bf2f(r[e] & 0xffffu); x[v][2 * e + 1] = bf2f(r[e] >> 16); } }
    if (NORM) { float ss = 0.f;
#pragma unroll
        for (int v = 0; v < V; ++v)
#pragma unroll
            for (int e = 0; e < 8; ++e) ss += x[v][e] * x[v][e];
        ss += __shfl_xor(ss, 1); ss += __shfl_xor(ss, 2); ss += __shfl_xor(ss, 4);
        const float r = rsqrtf(ss * (1.f / HD) + EPS);
#pragma unroll
        for (int v = 0; v < V; ++v) { const f32x4 g0 = *(const f32x4*)(gain + (part + 8 * v) * 8), g1 = *(const f32x4*)(gain + (part + 8 * v) * 8 + 4);
#pragma unroll
            for (int e = 0; e < 4; ++e) { x[v][e] *= r * g0[e]; x[v][4 + e] *= r * g1[e]; } } }
    if (ROT > 0) { constexpr int HL = ROT / 16 > 0 ? ROT / 16 : 1;
        float p[8];
#pragma unroll
        for (int e = 0; e < 8; ++e) p[e] = __shfl_xor(x[0][e], HL);
        if (part < 2 * HL) { const f32x2* rp = rope + (part & (HL - 1)) * 8; const bool lo = part < HL;
#pragma unroll
            for (int e = 0; e < 8; ++e) { const f32x2 cs = rp[e]; x[0][e] = lo ? x[0][e] * cs.x - p[e] * cs.y : x[0][e] * cs.x + p[e] * cs.y; } } }
#pragma unroll
    for (int v = 0; v < V; ++v) { u32x4 w; w.x = pk2(x[v][0], x[v][1]); w.y = pk2(x[v][2], x[v][3]); w.z = pk2(x[v][4], x[v][5]); w.w = pk2(x[v][6], x[v][7]);
        *(u32x4*)(dst + 64 * v) = w; }
}

template <int HD> struct H8R { u32x4 r[HD / 64]; };
template <int HD> struct H8G { f32x4 g[HD / 64][2]; };
struct H8C { f32x2 cs[8]; };
template <int HD> __device__ __forceinline__ void h8_load(H8R<HD>& a, const bf16* src0, const bf16* srcn) {
    a.r[0] = *(const u32x4*)src0;
#pragma unroll
    for (int v = 1; v < HD / 64; ++v) a.r[v] = *(const u32x4*)(srcn + 64 * (v - 1));
}
template <int HD> __device__ __forceinline__ void h8_gain(H8G<HD>& g, const float* gain, int part) {
#pragma unroll
    for (int v = 0; v < HD / 64; ++v) { g.g[v][0] = *(const f32x4*)(gain + (part + 8 * v) * 8); g.g[v][1] = *(const f32x4*)(gain + (part + 8 * v) * 8 + 4); }
}
template <int ROT> __device__ __forceinline__ void h8_rope(H8C& c, const f32x2* rope, int part) {
    constexpr int HL = ROT / 16 > 0 ? ROT / 16 : 1; const f32x2* rp = rope + (part & (HL - 1)) * 8;
#pragma unroll
    for (int e = 0; e < 8; ++e) c.cs[e] = rp[e];
}
template <int HD, int ROT, bool NORM>
__device__ __forceinline__ void h8_finish(const H8R<HD>& a, bf16* dst, const H8G<HD>& G, const H8C& C, int lane) {
    constexpr int V = HD / 64; const int part = lane & 7;
    float x[V][8];
#pragma unroll
    for (int v = 0; v < V; ++v)
#pragma unroll
        for (int e = 0; e < 4; ++e) { x[v][2 * e] = bf2f(a.r[v][e] & 0xffffu); x[v][2 * e + 1] = bf2f(a.r[v][e] >> 16); }
    if (NORM) { float ss = 0.f;
#pragma unroll
        for (int v = 0; v < V; ++v)
#pragma unroll
            for (int e = 0; e < 8; ++e) ss += x[v][e] * x[v][e];
        ss += __shfl_xor(ss, 1); ss += __shfl_xor(ss, 2); ss += __shfl_xor(ss, 4);
        const float r = rsqrtf(ss * (1.f / HD) + EPS);
#pragma unroll
        for (int v = 0; v < V; ++v)
#pragma unroll
            for (int e = 0; e < 4; ++e) { x[v][e] *= r * G.g[v][0][e]; x[v][4 + e] *= r * G.g[v][1][e]; } }
    if (ROT > 0) { constexpr int HL = ROT / 16 > 0 ? ROT / 16 : 1;
        float p[8];
#pragma unroll
        for (int e = 0; e < 8; ++e) p[e] = __shfl_xor(x[0][e], HL);
        if (part < 2 * HL) { const bool lo = part < HL;
#pragma unroll
            for (int e = 0; e < 8; ++e) { const f32x2 cs = C.cs[e]; x[0][e] = lo ? x[0][e] * cs.x - p[e] * cs.y : x[0][e] * cs.x + p[e] * cs.y; } } }
#pragma unroll
    for (int v = 0; v < V; ++v) { u32x4 w; w.x = pk2(x[v][0], x[v][1]); w.y = pk2(x[v][2], x[v][3]); w.z = pk2(x[v][4], x[v][5]); w.w = pk2(x[v][6], x[v][7]);
        *(u32x4*)(dst + 64 * v) = w; }
}

namespace fa {
#define SBAR() __builtin_amdgcn_sched_barrier(0)
typedef short s16x4 __attribute__((ext_vector_type(4)));
constexpr float LOG2E = 1.4426950408889634f;
constexpr float THR2 = 11.5f;
__device__ __forceinline__ int crow(int r, int hi) { return (r & 3) + 8 * (r >> 2) + 4 * hi; }
__device__ __forceinline__ unsigned cvtpk(float lo, float hi) { unsigned r; asm volatile("v_cvt_pk_bf16_f32 %0, %1, %2" : "=v"(r) : "v"(lo), "v"(hi)); return r; }
template <int DQK> __device__ __forceinline__ int kswz(int row, int colB) { return row * (DQK * 2) + (colB ^ ((DQK == 128 ? (row & 15) : ((row >> 1) & 7)) << 4)); }
__device__ __forceinline__ int v_st(int k, int c) { const int kk = (k & ~0xC) | ((k & 4) << 1) | ((k & 8) >> 1); return ((kk >> 3) * 4 + (c >> 5)) * 512 + ((kk & 7) * 32 + (c & 31)) * 2; }
__device__ __forceinline__ int v_rd_base(int lane) { return ((lane & 3) << 3) | (((lane >> 2) & 3) << 6) | (((lane >> 4) & 1) << 5) | (((lane >> 5) & 1) << 8); }
constexpr int v_rd_off(int d0, int ks, int half) { return d0 * 512 + ks * 4096 + half * 2048; }
template <int OFF> __device__ __forceinline__ s16x4 tr_read(int vb) { s16x4 r; asm volatile("ds_read_b64_tr_b16 %0, %1 offset:%2" : "=&v"(r) : "v"(vb), "i"(OFF) : "memory"); return r; }
template <int D0> __device__ __forceinline__ void pv_one(f32x16& od, int vb, bf16x8 pa0, bf16x8 pa1, bf16x8 pa2, bf16x8 pa3) {
    const s16x4 l0 = tr_read<v_rd_off(D0, 0, 0)>(vb), h0 = tr_read<v_rd_off(D0, 0, 1)>(vb), l1 = tr_read<v_rd_off(D0, 1, 0)>(vb), h1 = tr_read<v_rd_off(D0, 1, 1)>(vb);
    const s16x4 l2 = tr_read<v_rd_off(D0, 2, 0)>(vb), h2 = tr_read<v_rd_off(D0, 2, 1)>(vb), l3 = tr_read<v_rd_off(D0, 3, 0)>(vb), h3 = tr_read<v_rd_off(D0, 3, 1)>(vb);
    asm volatile("s_waitcnt lgkmcnt(0)" ::: "memory"); SBAR();
#define PK(L, H) (bf16x8){L[0], L[1], L[2], L[3], H[0], H[1], H[2], H[3]}
    od = __builtin_amdgcn_mfma_f32_32x32x16_bf16(pa0, PK(l0, h0), od, 0, 0, 0);
    od = __builtin_amdgcn_mfma_f32_32x32x16_bf16(pa1, PK(l1, h1), od, 0, 0, 0);
    od = __builtin_amdgcn_mfma_f32_32x32x16_bf16(pa2, PK(l2, h2), od, 0, 0, 0);
    od = __builtin_amdgcn_mfma_f32_32x32x16_bf16(pa3, PK(l3, h3), od, 0, 0, 0);
#undef PK
}
template <bool MSUM>
__device__ __forceinline__ void pv_d0(f32x16* o, f32x16& ol, int vb, bf16x8 pa0, bf16x8 pa1, bf16x8 pa2, bf16x8 pa3) {
    if constexpr (MSUM) {
    const bf16x8 ones = {0x3F80, 0x3F80, 0x3F80, 0x3F80, 0x3F80, 0x3F80, 0x3F80, 0x3F80};
    ol = __builtin_amdgcn_mfma_f32_32x32x16_bf16(pa0, ones, ol, 0, 0, 0); ol = __builtin_amdgcn_mfma_f32_32x32x16_bf16(pa1, ones, ol, 0, 0, 0);
    ol = __builtin_amdgcn_mfma_f32_32x32x16_bf16(pa2, ones, ol, 0, 0, 0); ol = __builtin_amdgcn_mfma_f32_32x32x16_bf16(pa3, ones, ol, 0, 0, 0); }
    pv_one<0>(o[0], vb, pa0, pa1, pa2, pa3); pv_one<1>(o[1], vb, pa0, pa1, pa2, pa3); pv_one<2>(o[2], vb, pa0, pa1, pa2, pa3); pv_one<3>(o[3], vb, pa0, pa1, pa2, pa3);
}
template <int DQK, int C> __device__ __forceinline__ void kfrag_load(bf16x8 (&kf)[8], const LAS unsigned char* Ks, int r32, int hi) {
#pragma unroll
    for (int i = 0; i < 4; ++i) { constexpr int d0b = 4 * C; if (d0b + i < DQK / 16) { const int cb = ((d0b + i) * 16 + hi * 8) * 2;
        kf[2 * i] = *(const LAS bf16x8*)(Ks + kswz<DQK>(r32, cb)); kf[2 * i + 1] = *(const LAS bf16x8*)(Ks + kswz<DQK>(32 + r32, cb)); } }
}
template <int DQK, int C> __device__ __forceinline__ void qkt_mma(f32x16& p0, f32x16& p1, const bf16x8 (&kf)[8], const bf16x8* qr) {
#pragma unroll
    for (int i = 0; i < 4; ++i) { constexpr int d0b = 4 * C; if (d0b + i < DQK / 16) {
        p0 = __builtin_amdgcn_mfma_f32_32x32x16_bf16(kf[2 * i], qr[d0b + i], p0, 0, 0, 0);
        p1 = __builtin_amdgcn_mfma_f32_32x32x16_bf16(kf[2 * i + 1], qr[d0b + i], p1, 0, 0, 0); } }
}
template <int DQK> __device__ __forceinline__ void qkt_rest(f32x16& p0, f32x16& p1, bf16x8 (&kfa)[8], const LAS unsigned char* Ks, const bf16x8* qr, int r32, int hi) {
    p0 = f32x16{}; p1 = f32x16{};
    SBAR(); qkt_mma<DQK, 0>(p0, p1, kfa, qr);
    if constexpr (DQK > 64) { SBAR(); kfrag_load<DQK, 1>(kfa, Ks, r32, hi); SBAR(); qkt_mma<DQK, 1>(p0, p1, kfa, qr); }
    if constexpr (DQK > 128) { SBAR(); kfrag_load<DQK, 2>(kfa, Ks, r32, hi); SBAR(); qkt_mma<DQK, 2>(p0, p1, kfa, qr); }
}
template <bool PRESCALED>
__device__ __forceinline__ void partialSM(f32x16& p0, f32x16& p1, float& m_reg, float& alpha, float C) {
    float pmax = p0[0];
#pragma unroll
    for (int r = 1; r < 16; ++r) pmax = fmaxf(pmax, p0[r]);
#pragma unroll
    for (int r = 0; r < 16; ++r) pmax = fmaxf(pmax, p1[r]);
    { auto rr = __builtin_amdgcn_permlane32_swap(__float_as_uint(pmax), __float_as_uint(pmax), false, false);
      pmax = fmaxf(__uint_as_float(rr[0]), __uint_as_float(rr[1])); }
    if (!PRESCALED) pmax *= C;
    float mn;
    if (__builtin_expect(__all(pmax - m_reg <= THR2), 1)) { mn = m_reg; alpha = 1.f; }
    else { mn = fmaxf(m_reg, pmax); alpha = __builtin_amdgcn_exp2f(m_reg - mn); m_reg = mn; }
    if (PRESCALED) {
#pragma unroll
        for (int r = 0; r < 16; ++r) { p0[r] -= mn; p1[r] -= mn; }
    } else { const float nm = -mn;
#pragma unroll
        for (int r = 0; r < 16; ++r) { p0[r] = fmaf(p0[r], C, nm); p1[r] = fmaf(p1[r], C, nm); } }
#pragma unroll
    for (int r = 0; r < 16; ++r) p0[r] = __builtin_amdgcn_exp2f(p0[r]);
}
template <bool MSUM>
__device__ __forceinline__ void finishSM(f32x16& p0, f32x16& p1, float alpha, float& l_reg, bf16x8& pa0, bf16x8& pa1, bf16x8& pa2, bf16x8& pa3) {
#pragma unroll
    for (int r = 0; r < 16; ++r) p1[r] = __builtin_amdgcn_exp2f(p1[r]);
    if constexpr (!MSUM) { float ps = 0;
#pragma unroll
        for (int r = 0; r < 16; ++r) ps += p0[r];
#pragma unroll
        for (int r = 0; r < 16; ++r) ps += p1[r];
        { auto rr = __builtin_amdgcn_permlane32_swap(__float_as_uint(ps), __float_as_uint(ps), false, false);
          ps = __uint_as_float(rr[0]) + __uint_as_float(rr[1]); }
        l_reg = l_reg * alpha + ps; }
#define PK4(P, BASE, OUT) do { unsigned a0 = cvtpk(P[BASE + 0], P[BASE + 1]), a1 = cvtpk(P[BASE + 2], P[BASE + 3]);   \
    unsigned b0 = cvtpk(P[BASE + 4], P[BASE + 5]), b1 = cvtpk(P[BASE + 6], P[BASE + 7]);                              \
    auto r0 = __builtin_amdgcn_permlane32_swap(a0, b0, false, false); auto r1 = __builtin_amdgcn_permlane32_swap(a1, b1, false, false); \
    u32x4 w = {r0[0], r1[0], r0[1], r1[1]}; OUT = __builtin_bit_cast(bf16x8, w); } while (0)
    PK4(p0, 0, pa0); PK4(p0, 8, pa1); PK4(p1, 0, pa2); PK4(p1, 8, pa3);
#undef PK4
}
struct AttnP { const bf16* Q; const bf16* K; const bf16* V; bf16* O; float C; const u64* mask; const float* cum; const bf16* gate; float lam, oscale; const float* subg; float* O1; };
template <int QRS_, int QHS_, int KRS_, int KHS_, int VRS_, int VHS_, int GRS_> struct Strides { static constexpr int q_rs = QRS_, q_hs = QHS_, k_rs = KRS_, k_hs = KHS_, v_rs = VRS_, v_hs = VHS_, g_rs = GRS_; };
template <int MODE, int DQK, class ST>
__device__ __forceinline__ void attn_unit(const AttnP& A, const int h, const int qb, LAS unsigned char* lds, const int wave) {
    constexpr int SHM_V = 64 * 128 * 2, SHM_K = 64 * DQK * 2, CPR = DQK / 8, KCH = DQK / 64, RING = 3 * SHM_V + 3 * SHM_K;
    const int tid = tid_of(wave), wid = wave,
    lane_m = tid & 63, r32_m = lane_m & 31, hi_m = lane_m >> 5;
    LAS unsigned char* V_lds = lds; LAS unsigned char* K_lds = lds + 3 * SHM_V;
    LAS float* wsf = (LAS float*)(lds + RING) + wid * 64; LAS float* li_l = wsf; LAS float* al_l = wsf + 32;
    LAS float* cumL = (LAS float*)(lds + RING + 2048);
    static_assert(RING + 2048 + (MODE == 3 ? 32768 : 0) <= MISC_OFF, "attention LDS map");
    const int q0 = qb * 256, NT = (q0 + 256) / 64, qrow_m = q0 + wid * 32 + r32_m;
    float cq2 = 0.f;
    if (MODE == 3) {
#pragma unroll 1
        for (int i = tid; i < (q0 + 256) / 4; i += 512) *(LAS f32x4*)(cumL + 4 * i) = *(const f32x4*)(A.cum + (size_t)h * S + 4 * i);
        __syncthreads(); cq2 = cumL[qrow_m]; }
#pragma unroll 1
    for (int pass = 0; pass < (MODE == 2 ? 2 : 1); ++pass) {
    const int qh = MODE == 2 ? 2 * h + pass : h;
    const bf16* Kh = A.K + qh * ST::k_hs; const bf16* Vh = A.V + h * ST::v_hs;
    constexpr bool MSUM = DQK <= 128;
    float l_reg = 0.f; f32x16 o[4] = {}; f32x16 ol = {};
    {
    const int lane = lane_m, r32 = r32_m, hi = hi_m, qrow = qrow_m; float m_reg = -1e30f; bf16x8 qr[DQK / 16];
    { const bf16* Qw = A.Q + (size_t)qrow * ST::q_rs + qh * ST::q_hs + hi * 8;
#pragma unroll
      for (int d0 = 0; d0 < DQK / 16; ++d0) qr[d0] = *(const bf16x8*)(Qw + d0 * 16); }
    const int sr = tid >> 4, sc = (tid & 15) * 8, vst0 = v_st(sr, sc), vst1 = v_st(32 + sr, sc);
    unsigned kgo[KCH]; int klo[KCH];
#pragma unroll
    for (int i = 0; i < KCH; ++i) { const int q = tid + 512 * i, row = q / CPR, ch = q % CPR; kgo[i] = (unsigned)(row * ST::k_rs + ch * 8); klo[i] = kswz<DQK>(row, ch * 16); }
    const unsigned vgo0 = (unsigned)(sr * ST::v_rs + sc), vgo1 = (unsigned)((32 + sr) * ST::v_rs + sc);
    const int vb0 = (int)(unsigned)(uintptr_t)V_lds + v_rd_base(lane);
    struct { bf16x8 vs0, vs1; bf16x8 ks[KCH]; } sr_[1];
#define SLOAD(i, k0) do { const bf16* vb_ = Vh + (size_t)(k0) * ST::v_rs; const bf16* kb_ = Kh + (size_t)(k0) * ST::k_rs; \
    sr_[i].vs0 = *(const bf16x8*)(vb_ + vgo0); sr_[i].vs1 = *(const bf16x8*)(vb_ + vgo1); \
    _Pragma("unroll") for (int _k = 0; _k < KCH; ++_k) sr_[i].ks[_k] = *(const bf16x8*)(kb_ + kgo[_k]); } while (0)
#define SWRITE(b, i) do { *(LAS bf16x8*)(V_lds + (b) * SHM_V + vst0) = sr_[i].vs0; *(LAS bf16x8*)(V_lds + (b) * SHM_V + vst1) = sr_[i].vs1; \
    _Pragma("unroll") for (int _k = 0; _k < KCH; ++_k) *(LAS bf16x8*)(K_lds + (b) * SHM_K + klo[_k]) = sr_[i].ks[_k]; } while (0)
#define SWAIT() asm volatile("s_waitcnt vmcnt(0)" ::: "memory")
#define BAR() asm volatile("s_waitcnt lgkmcnt(0)\n\ts_barrier" ::: "memory")
#define RESC(a) do { if (__any((a) < 1.f)) { int l_; asm volatile("v_mbcnt_lo_u32_b32 %0, -1, 0\n\tv_mbcnt_hi_u32_b32 %0, -1, %0" : "=v"(l_));   \
    if (l_ < 32) al_l[l_] = (a); asm volatile("s_waitcnt lgkmcnt(0)" ::: "memory"); const int h_ = l_ >> 5; \
    _Pragma("unroll") for (int r = 0; r < 16; ++r) { const float f_ = al_l[crow(r, h_)]; if (MSUM) ol[r] *= f_; _Pragma("unroll") for (int d = 0; d < 4; ++d) o[d][r] *= f_; } } } while (0)
    int mG = -1; u64 mw0 = 0, mw1 = 0, mw2 = 0, mw3 = 0;
    u32x4 nx0, nx1;
    { const u32x4* mp = (const u32x4*)((MODE == 1 ? A.mask : (const u64*)A.Q) + (MODE == 1 ? (size_t)qrow * 128 : 0)); nx0 = mp[0]; nx1 = mp[1]; }
#define FIX(P0, P1, T) do { \
    if (MODE == 0 || MODE == 2 || MODE == 3) { if (MODE == 3) { const LAS float* cl = cumL + (T) * 64 + 4 * hi; \
            _Pragma("unroll") for (int jj = 0; jj < 4; ++jj) { const f32x4 c0 = *(const LAS f32x4*)(cl + 8 * jj), c1 = *(const LAS f32x4*)(cl + 32 + 8 * jj); \
                _Pragma("unroll") for (int i = 0; i < 4; ++i) { P0[4 * jj + i] = fmaf(P0[4 * jj + i], A.C, cq2 - c0[i]); P1[4 * jj + i] = fmaf(P1[4 * jj + i], A.C, cq2 - c1[i]); } SBAR(); } } \
        if ((T) >= NT - 4) { const int kb = 64 * ((T) - (NT - 4)) + 4 * hi, qrel = wid * 32 + r32; \
            _Pragma("unroll") for (int r = 0; r < 16; ++r) { const int kv = kb + (r & 3) + 8 * (r >> 2); if (kv > qrel) P0[r] = -INFINITY; if (kv + 32 > qrel) P1[r] = -INFINITY; } } } \
    if (MODE == 1) { if (((T) >> 2) != mG) { mG = (T) >> 2;             \
            mw0 = (u64)nx0.x | ((u64)nx0.y << 32); mw1 = (u64)nx0.z | ((u64)nx0.w << 32); mw2 = (u64)nx1.x | ((u64)nx1.y << 32); mw3 = (u64)nx1.z | ((u64)nx1.w << 32); \
            { const int gn_ = 4 * (mG + 1) < NT ? mG + 1 : mG; const u32x4* mp = (const u32x4*)(A.mask + ((size_t)qrow * 32 + gn_) * 4); nx0 = mp[0]; nx1 = mp[1]; } } \
        const int sh = 16 * ((T) & 3) + hi; const unsigned b0 = (unsigned)(mw0 >> sh), b1 = (unsigned)(mw1 >> sh), b2 = (unsigned)(mw2 >> sh), b3 = (unsigned)(mw3 >> sh); \
        _Pragma("unroll") for (int jj = 0; jj < 4; ++jj) { \
            if (!((b0 >> (2 * jj)) & 1u)) P0[4 * jj + 0] = -INFINITY; if (!((b1 >> (2 * jj)) & 1u)) P0[4 * jj + 1] = -INFINITY; \
            if (!((b2 >> (2 * jj)) & 1u)) P0[4 * jj + 2] = -INFINITY; if (!((b3 >> (2 * jj)) & 1u)) P0[4 * jj + 3] = -INFINITY; \
            if (!((b0 >> (8 + 2 * jj)) & 1u)) P1[4 * jj + 0] = -INFINITY; if (!((b1 >> (8 + 2 * jj)) & 1u)) P1[4 * jj + 1] = -INFINITY; \
            if (!((b2 >> (8 + 2 * jj)) & 1u)) P1[4 * jj + 2] = -INFINITY; if (!((b3 >> (8 + 2 * jj)) & 1u)) P1[4 * jj + 3] = -INFINITY; } } } while (0)
    constexpr bool PRE = (MODE == 3);
    {
        const int grp = wid >> 2;
        f32x16 p0, p1; float al = 1.f; bf16x8 pa0, pa1, pa2, pa3;
        SLOAD(0, 0); SWAIT(); SWRITE(0, 0); SLOAD(0, 64); BAR();
        if (grp == 1) BAR();
        bf16x8 kfa[8];
        SWAIT(); SWRITE(1, 0); kfrag_load<DQK, 0>(kfa, K_lds, r32, hi); SBAR(); qkt_rest<DQK>(p0, p1, kfa, K_lds, qr, r32, hi); BAR();
        int s_prev = 0, s_cur = 1, s_next = 2;
#pragma unroll 1
        for (int m = 1; m < NT; ++m) {
            if (m + 1 < NT) SLOAD(0, (m + 1) * 64);
            SBAR(); FIX(p0, p1, m - 1); partialSM<PRE>(p0, p1, m_reg, al, A.C); finishSM<MSUM>(p0, p1, al, l_reg, pa0, pa1, pa2, pa3); BAR();
            if (m + 1 < NT) { SWAIT(); SWRITE(s_next, 0); }
            kfrag_load<DQK, 0>(kfa, K_lds + s_cur * SHM_K, r32, hi);
            RESC(al); SBAR();
            pv_d0<MSUM>(o, ol, vb0 + s_prev * SHM_V, pa0, pa1, pa2, pa3); SBAR();
            qkt_rest<DQK>(p0, p1, kfa, K_lds + s_cur * SHM_K, qr, r32, hi); BAR();
            { const int t_ = s_prev; s_prev = s_cur; s_cur = s_next; s_next = t_; }
        }
        SBAR(); FIX(p0, p1, NT - 1); partialSM<PRE>(p0, p1, m_reg, al, A.C); finishSM<MSUM>(p0, p1, al, l_reg, pa0, pa1, pa2, pa3); BAR();
        RESC(al); SBAR();
        pv_d0<MSUM>(o, ol, vb0 + s_prev * SHM_V, pa0, pa1, pa2, pa3);
        if (grp == 0) BAR();
    }
    }
    asm volatile("s_waitcnt vmcnt(0)" ::: "memory");
    int lane_e; asm volatile("v_mbcnt_lo_u32_b32 %0, -1, 0\n\tv_mbcnt_hi_u32_b32 %0, -1, %0" : "=v"(lane_e));
    const int r32 = lane_e & 31, hi = lane_e >> 5, lane = lane_e;
    float rli[16];
    if constexpr (MSUM) {
#pragma unroll
        for (int r = 0; r < 16; ++r) rli[r] = __builtin_amdgcn_rcpf(ol[r]);
    } else { if (hi == 0) li_l[r32] = l_reg; asm volatile("s_waitcnt lgkmcnt(0)" ::: "memory");
#pragma unroll
        for (int r = 0; r < 16; ++r) rli[r] = __builtin_amdgcn_rcpf(li_l[crow(r, hi)]); }
#pragma unroll
    for (int d0 = 0; d0 < 4; ++d0)
#pragma unroll
        for (int r = 0; r < 16; ++r) o[d0][r] *= rli[r];
    if (MODE == 2 && pass == 0) {
        float* Ow = A.O1 + (size_t)(q0 + wid * 32) * D + h * 128;
#pragma unroll
        for (int r = 0; r < 16; ++r)
#pragma unroll
            for (int d0 = 0; d0 < 4; ++d0) Ow[(size_t)crow(r, hi) * D + d0 * 32 + r32] = o[d0][r];
        asm volatile("s_waitcnt vmcnt(0)" ::: "memory"); __syncthreads();
        continue;
    }
    if (MODE == 2) {
        const float* Ow = A.O1 + (size_t)(q0 + wid * 32) * D + h * 128;
#pragma unroll
        for (int r = 0; r < 16; ++r) { float ss = 0.f;
#pragma unroll
            for (int d0 = 0; d0 < 4; ++d0) { const float v = Ow[(size_t)crow(r, hi) * D + d0 * 32 + r32] - A.lam * o[d0][r]; o[d0][r] = v; ss += v * v; }
#pragma unroll
            for (int off = 16; off >= 1; off >>= 1) ss += __shfl_xor(ss, off);
            const float rs = rsqrtf(ss * (1.f / 128.f) + EPS) * A.oscale;
#pragma unroll
            for (int d0 = 0; d0 < 4; ++d0) o[d0][r] *= rs * A.subg[d0 * 32 + r32]; }
    }
    __syncthreads();
    { LAS unsigned char* stg = lds + wid * (32 * 272);
#pragma unroll
      for (int r = 0; r < 16; ++r)
#pragma unroll
          for (int d0 = 0; d0 < 4; ++d0) *(LAS unsigned short*)(stg + crow(r, hi) * 272 + (d0 * 32 + r32) * 2) = (unsigned short)f2bf(o[d0][r]);
      asm volatile("s_waitcnt lgkmcnt(0)" ::: "memory");
#pragma unroll
      for (int i = 0; i < 8; ++i) { const int row = i * 4 + (lane >> 4), ch = lane & 15; u32x4 v = *(const LAS u32x4*)(stg + row * 272 + ch * 16);
          const size_t grow = (size_t)(q0 + wid * 32 + row);
          if (MODE == 3) { const u32x4 gv = *(const u32x4*)(A.gate + grow * ST::g_rs + h * 128 + ch * 8);
#pragma unroll
              for (int e = 0; e < 4; ++e) { const float g0 = bf2f(gv[e] & 0xffffu), g1 = bf2f(gv[e] >> 16), x0 = bf2f(v[e] & 0xffffu), x1 = bf2f(v[e] >> 16);
                  v[e] = pk2(x0 * __builtin_amdgcn_rcpf(1.f + __expf(-g0)), x1 * __builtin_amdgcn_rcpf(1.f + __expf(-g1))); } }
          *(u32x4*)(A.O + grow * D + h * 128 + ch * 8) = v; } }
    asm volatile("s_waitcnt vmcnt(0) lgkmcnt(0)" ::: "memory"); __syncthreads();
    }
#undef SLOAD
#undef SWRITE
#undef SWAIT
#undef BAR
#undef RESC
#undef FIX
}
template <int MODE, int DQK, class ST>
__device__ __forceinline__ void attn_phase(const AttnP& A, LAS unsigned char* lds, int blk, int G, int wave) {
    const int vcu = (G % 8 == 0) ? (blk % 8) * (G / 8) + blk / 8 : blk;
    for (int p = vcu; p < 256; p += G) { const int h = p >> 4, s2 = p & 15;
        attn_unit<MODE, DQK, ST>(A, h, 31 - s2, lds, wave); attn_unit<MODE, DQK, ST>(A, h, s2, lds, wave); }
}
#undef SBAR
}

__device__ __forceinline__ void score_mfma(const bf16* P, const float* IW, float* SIDX, const Ctx& c) {
    const bool dealt = c.ngw == 2048;
    const int wv = c.wave * c.G + c.blk;
#pragma unroll 1
    for (int it = 0; it < (dealt ? (wv < 1792 ? 1 : 2) : (2304 - c.gw + c.ngw - 1) / c.ngw); ++it) {
        int lane = c.lane; asm volatile("" : "+v"(lane));
        const int l16 = lane & 15, kg = lane >> 4;
        int qg, kc;
        if (dealt && wv < 1792) { int j = 1;
#pragma unroll
            for (int jj = 2; jj < 8; ++jj) if (wv >= 32 * jj * (jj - 1)) j = jj;
            const int local = wv - 32 * j * (j - 1); qg = 64 * j + local / j; kc = local % j; }
        else if (dealt) { const int r = wv - 1792, j = r >> 5, i = r & 31; qg = 64 * j + (it == 0 ? 63 - i : i); kc = j; }
        else { const int task = c.gw + it * c.ngw; int j = 0;
#pragma unroll
            for (int jj = 1; jj < 8; ++jj) if (task >= 32 * jj * (jj + 1)) j = jj;
            const int local = task - 32 * j * (j + 1); qg = 64 * j + local / (j + 1); kc = local % (j + 1); }
        const int t0 = 16 * qg;
        const bf16* qp = P + (size_t)(t0 + l16) * N_DSA_IN + 6144 + 8 * kg;
        bf16x8 bq[16][2]; float w[16];
#pragma unroll
        for (int h = 0; h < 16; ++h) { bq[h][0] = *(const bf16x8*)(qp + h * 64); bq[h][1] = *(const bf16x8*)(qp + h * 64 + 32); w[h] = IW[(t0 + l16) * 16 + h] * 0.0625f; }
        bf16x8 bl[2];
#pragma unroll
        for (int u2 = 0; u2 < 2; ++u2) { float sacc[8] = {0.f, 0.f, 0.f, 0.f, 0.f, 0.f, 0.f, 0.f};
#pragma unroll
            for (int h = 0; h < 16; ++h)
#pragma unroll
                for (int e = 0; e < 8; ++e) sacc[e] += w[h] * bf2f((unsigned short)bq[h][u2][e]);
            u32x4 pk; pk.x = pk2(sacc[0], sacc[1]); pk.y = pk2(sacc[2], sacc[3]); pk.z = pk2(sacc[4], sacc[5]); pk.w = pk2(sacc[6], sacc[7]); bl[u2] = __builtin_bit_cast(bf16x8, pk); }
        const int kend = (1024 * kc + 1024) < (t0 + 16) ? (1024 * kc + 1024) : (t0 + 16);
        const bf16* kp = P + (size_t)(1024 * kc + l16) * N_DSA_IN + 7168 + 8 * kg;
        float* op = SIDX + (size_t)(t0 + l16) * S + 1024 * kc + 4 * kg;
        bf16x8 a0 = *(const bf16x8*)kp, a1 = *(const bf16x8*)(kp + 32);
        for (int k0 = 1024 * kc; k0 < kend; k0 += 16) {
            const bf16x8 c0 = a0, c1 = a1;
            if (k0 + 16 < kend) { kp += (size_t)16 * N_DSA_IN; a0 = *(const bf16x8*)kp; a1 = *(const bf16x8*)(kp + 32); }
            f32x4 acc = {0.f, 0.f, 0.f, 0.f};
            acc = __builtin_amdgcn_mfma_f32_16x16x32_bf16(c0, bl[0], acc, 0, 0, 0);
            acc = __builtin_amdgcn_mfma_f32_16x16x32_bf16(c1, bl[1], acc, 0, 0, 0);
            f32x4 dc = {0.f, 0.f, 0.f, 0.f}, dm = {0.f, 0.f, 0.f, 0.f};
            dc = __builtin_amdgcn_mfma_f32_16x16x32_bf16(c0, bq[0][0], dc, 0, 0, 0); dm = __builtin_amdgcn_mfma_f32_16x16x32_bf16(c0, bq[1][0], dm, 0, 0, 0);
            dc = __builtin_amdgcn_mfma_f32_16x16x32_bf16(c1, bq[0][1], dc, 0, 0, 0); dm = __builtin_amdgcn_mfma_f32_16x16x32_bf16(c1, bq[1][1], dm, 0, 0, 0);
#pragma unroll
            for (int h = 0; h < 16; ++h) { f32x4 dn = {0.f, 0.f, 0.f, 0.f};
                if (h + 2 < 16) { dn = __builtin_amdgcn_mfma_f32_16x16x32_bf16(c0, bq[h + 2 < 16 ? h + 2 : 15][0], dn, 0, 0, 0);
                                  dn = __builtin_amdgcn_mfma_f32_16x16x32_bf16(c1, bq[h + 2 < 16 ? h + 2 : 15][1], dn, 0, 0, 0); }
                else asm volatile("s_nop 7\n\ts_nop 7\n\ts_nop 7" ::: "memory");
                if (h == 0) { __builtin_amdgcn_sched_barrier(0); asm volatile("s_nop 7\n\ts_nop 7\n\ts_nop 7" ::: "memory"); }
                __builtin_amdgcn_sched_barrier(0);
#pragma unroll
                for (int i = 0; i < 4; ++i) asm volatile("v_fma_f32 %0, %1, |%2|, %0" : "+v"(acc[i]) : "v"(w[h]), "v"(dc[i]));
                __builtin_amdgcn_sched_barrier(0);
                dc = dm; dm = dn; }
            *(f32x4*)op = acc; op += 16;
        }
    }
}
__device__ __forceinline__ void select_phase(const float* SIDX, u64* MASK, const Ctx& c) {
    const int q4 = c.tid >> 7, t128 = c.tid & 127, w2 = t128 >> 6, lane = c.lane;
    LAS unsigned* hist = (LAS unsigned*)(c.lds + q4 * 16384);
    volatile LAS unsigned* wt = (volatile LAS unsigned*)(c.lds + 65536 + q4 * 64);
    u32x4 nv[16];
    { const int t0_ = 4 * c.blk + q4;
#pragma unroll
      for (int j = 0; j < 16; ++j) { const int base = 512 * j + 4 * t128; nv[j] = *(const u32x4*)(SIDX + (size_t)t0_ * S + (base <= t0_ ? base : 0)); } }
#pragma unroll 1
    for (int grp = c.blk; grp < S / 4; grp += c.G) {
        const int t = 4 * grp + q4;
        unsigned u[64];
#pragma unroll
        for (int j = 0; j < 16; ++j) { const int base = 512 * j + 4 * t128;
            const u32x4 v = nv[j];
#pragma unroll
            for (int e = 0; e < 4; ++e) { const unsigned b = v[e]; const unsigned o = (b & 0x80000000u) ? ~b : (b | 0x80000000u);
                u[4 * j + e] = (base + e <= t) ? o : 0u; } }
        { const int gn_ = grp + c.G < S / 4 ? grp + c.G : grp; const int tn_ = 4 * gn_ + q4;
#pragma unroll
          for (int j = 0; j < 16; ++j) { const int base = 512 * j + 4 * t128; nv[j] = *(const u32x4*)(SIDX + (size_t)tn_ * S + (base <= tn_ ? base : 0)); } }
        unsigned krem = (unsigned)(t + 1 < 256 ? t + 1 : 256), prefix = 0u;
        unsigned lmin;
        { unsigned m1 = 0u, m2 = 0u;
#pragma unroll
          for (int j = 0; j < 16; ++j) if (512 * j <= t)
#pragma unroll
            for (int e = 0; e < 4; ++e) { const int i = 4 * j + e; const unsigned lo = u[i] < m1 ? u[i] : m1; m2 = lo > m2 ? lo : m2; m1 = u[i] > m1 ? u[i] : m1; }
          unsigned lm = m2;
#pragma unroll
          for (int o = 32; o >= 1; o >>= 1) { const unsigned n = __shfl_xor(lm, o); lm = n < lm ? n : lm; }
          if (lane == 0) wt[12 + w2] = lm;
          __syncthreads();
          lmin = wt[12]; { const unsigned a1 = wt[13]; lmin = a1 < lmin ? a1 : lmin; } }
#pragma unroll
        for (int pass = 0; pass < 3; ++pass) {
            const int shift = pass == 0 ? 20 : (pass == 1 ? 8 : 0); const unsigned dmask = pass == 2 ? 0xFFu : 0xFFFu;
            const int pshift = pass == 0 ? 32 : (pass == 1 ? 20 : 8);
#pragma unroll
            for (int i = 0; i < 32; ++i) hist[t128 + 128 * i] = 0u;
            __syncthreads();
#pragma unroll
            for (int j = 0; j < 16; ++j) if (512 * j <= t)
#pragma unroll
              for (int e = 0; e < 4; ++e) { const int i = 4 * j + e; const bool match = pass == 0 ? (u[i] >= lmin && u[i] != 0u) : ((u[i] >> pshift) == prefix && u[i] >= lmin);
                if (match) atomicAdd((unsigned*)&hist[(u[i] >> shift) & dmask], 1u); }
            __syncthreads();
            unsigned loc = 0u;
#pragma unroll
            for (int i = 0; i < 32; ++i) loc += hist[32 * t128 + i];
            unsigned incl = loc;
#pragma unroll
            for (int o = 1; o < 64; o <<= 1) { const unsigned n = __shfl_down(incl, o); if (lane + o < 64) incl += n; }
            if (lane == 0) wt[w2] = incl;
            __syncthreads();
            const unsigned above = w2 == 0 ? wt[1] : 0u;
            incl += above; const unsigned excl = incl - loc;
            if (excl < krem && krem <= incl) { unsigned cnt = excl;
                for (int b = 31; b >= 0; --b) { const unsigned hb = hist[32 * t128 + b];
                    if (cnt + hb >= krem) { wt[8] = (unsigned)(32 * t128 + b); wt[9] = krem - cnt; break; } cnt += hb; } }
            __syncthreads();
            prefix = (pass == 0) ? wt[8] : (pass == 1 ? ((prefix << 12) | wt[8]) : ((prefix << 8) | wt[8]));
            krem = wt[9];
        }
        const unsigned thr = prefix;
#pragma unroll
        for (int j = 0; j < 16; ++j) { if (512 * j <= t) {
#pragma unroll
            for (int e = 0; e < 4; ++e) { const u64 bal = __ballot(u[4 * j + e] >= thr && u[4 * j + e] != 0u);
                if (lane == 0) MASK[((size_t)t * 32 + (2 * j + w2)) * 4 + e] = bal; } } }
        __syncthreads();
    }
}


__device__ __forceinline__ void ph_cumsum(const float* logf, float* cum, const Ctx& c) {
    if (c.blk >= NH) return;
    LAS float* wsum = (LAS float*)c.lds; const int h = c.blk, tid = c.tid;
    float v[16];
    { const f32x4* lp = (const f32x4*)(logf + (size_t)h * S + 16 * tid);
#pragma unroll
      for (int k = 0; k < 4; ++k) { const f32x4 x = lp[k]; v[4 * k] = x.x; v[4 * k + 1] = x.y; v[4 * k + 2] = x.z; v[4 * k + 3] = x.w; } }
#pragma unroll
    for (int k = 1; k < 16; ++k) v[k] += v[k - 1];
    const float tot = v[15]; float incl = tot;
#pragma unroll
    for (int o2 = 1; o2 < 64; o2 <<= 1) { const float nb = __shfl_up(incl, o2); if (c.lane >= o2) incl += nb; }
    if (c.lane == 63) wsum[c.wave] = incl;
    __syncthreads();
    float base = incl - tot;
    for (int w = 0; w < c.wave; ++w) base += wsum[w];
    f32x4* op = (f32x4*)(cum + (size_t)h * S + 16 * tid);
#pragma unroll
    for (int k = 0; k < 4; ++k) op[k] = (f32x4){(v[4 * k] + base) * fa::LOG2E, (v[4 * k + 1] + base) * fa::LOG2E, (v[4 * k + 2] + base) * fa::LOG2E, (v[4 * k + 3] + base) * fa::LOG2E};
}
constexpr int NPHASE = 32;
#ifndef MK_PER_PHASE
#define MK_PER_PHASE 0
#endif
__global__ void __launch_bounds__(512, 2) mega(Args a) {
    extern __shared__ __attribute__((aligned(16))) unsigned char lds_raw[];
    Ctx c; c.lds = (LAS unsigned char*)lds_raw; c.tid = threadIdx.x; c.lane = c.tid & 63; c.wave = __builtin_amdgcn_readfirstlane(c.tid >> 6);
    c.G = gridDim.x; c.blk = blockIdx.x; c.gw = c.blk * 8 + c.wave; c.ngw = c.G * 8;
    volatile LAS unsigned* MISC = (volatile LAS unsigned*)(c.lds + MISC_OFF);
    if (c.tid < 32) MISC[c.tid] = 0u;
    __syncthreads();
    unsigned* ctl = (unsigned*)(a.ws + WS_CTL);
    XcdBarrier bar; bar.bar = ctl + CW_BAR; bar.x = 0; bar.st = nullptr; bar.wave = c.wave;
    const int lo = a.ph_lo, hi = a.ph_hi;
    if (hi - lo > 1) bar = xcd_barrier_post(ctl + CW_BAR, MISC + 8, c.wave);
#define IN(k) (lo <= (k) && (k) < hi && (fresh(c), ws = launder_ptr(a.ws), true))
#define SEAM(k) do { if (lo <= (k) && (k) + 1 < hi) xcd_barrier(bar); } while (0)
    unsigned char* ws = a.ws;
#define mod ((float*)(ws + WS_MOD))
#define XB ((bf16*)(ws + WS_XB))
#define P ((bf16*)(ws + WS_P))
#define Ob ((bf16*)(ws + WS_O))
#define HID ((bf16*)(ws + WS_HID))
#define STAT ((float*)(ws + WS_STAT))
#define BIAS ((float*)(ws + WS_BIAS))
#define BIASP ((const float*)(ws + WS_BIASP))
#define xin ((const float*)a.in[I_X])
#define out (a.out)
#define R64 ((const f32x2*)(ws + WS_ROPE64))
#define R32 ((const f32x2*)(ws + WS_ROPE32))
#define R16 ((const f32x2*)(ws + WS_ROPE16))
#define PM ((bf16*)(ws + WS_PM))
#define CN ((bf16*)(ws + WS_CN))
#define QRAW P
#define KVRAW ((bf16*)(ws + WS_P + 48 * MiB))
#define Qb ((bf16*)(ws + WS_Q))
#define Kb ((bf16*)(ws + WS_K))
#define IW ((float*)(ws + WS_IW))
#define SIDX ((float*)(ws + WS_SIDX))
#define MASK ((u64*)(ws + WS_MASK))
#define LOGF ((float*)(ws + WS_LOGF))

    if (IN(0)) ph_phase0(a, c);
    SEAM(0);
    if (IN(1)) ph_modfinal(a, c);
    SEAM(1);
    if (IN(2)) ph_weights(a, c);
    SEAM(2);

#define WIN(PH, WOFF, NN, BO, OUTP, NHT) \
    if (IN(PH)) { if ((PH) == 3) { bias_all(BIASP, BIAS, N_MLA_IN, c); bias_reduce(BIASP + (BO), BIAS + (BO), S, NN, c.G, c.blk, c.wave, NHT); } pg8::EpiStoreP EP{OUTP, NN, STAT, BIAS + (BO)}; GEMM_SITE(EP, XB, D, (const bf16*)(ws + (WOFF)), D, S, NN, D, NHT); } \
    SEAM(PH);
#define WOUT(L, PH, XSRC) \
    if (IN(PH)) { pg8::EpiResP<false> EP{XB, (bf16*)(ws + WS_XL), mod + (L) * NMOD + 2 * D, STAT, nullptr}; GEMM_SITE(EP, Ob, D, (const bf16*)(ws + WS_W_OUT + (size_t)(L) * 8 * MiB), D, S, D, D, 0); } \
    SEAM(PH);
#define FFN_PHASES(L, P0) \
    if (IN(P0)) { pg8::EpiSwigluP EP{HID, STAT, BIAS + BO_GU + (L) * 2 * FF}; \
        GEMM_SITE(EP, XB, D, (const bf16*)(ws + WS_W_GU + (size_t)(L) * 44 * MiB), D, S, 2 * FF, D, 4); } \
    SEAM(P0); \
    if (IN(P0 + 1)) { pg8::EpiResP<(L) == 3> EP{XB, (bf16*)(ws + WS_XL), mod + (L) * NMOD + 5 * D, STAT, out}; GEMM_SITE(EP, HID, FF, (const bf16*)(ws + WS_W_DN + (size_t)(L) * 22 * MiB), FF, S, D, FF, 0); } \
    if ((P0) + 1 < NPHASE - 1) SEAM(P0 + 1);

    WIN(3, WS_W_MLA_IN, N_MLA_IN, BO_MLA, PM, 0)
    if (IN(4)) {
        const float* gq = (const float*)a.in[I_MLA_QAG]; const float* gkv = (const float*)a.in[I_MLA_KVAG];
        const int hf = c.lane >> 5, l32 = c.lane & 31;
        float g[16];
        { const float* gp = (hf ? gkv : gq) + l32 * 16;
#pragma unroll
          for (int e = 0; e < 4; ++e) { const f32x4 gv = *(const f32x4*)(gp + 4 * e); g[4 * e] = gv.x; g[4 * e + 1] = gv.y; g[4 * e + 2] = gv.z; g[4 * e + 3] = gv.w; } }
        bf16x8 n0, n1;
        { const bf16* src = PM + (size_t)(c.gw < S ? c.gw : 0) * N_MLA_IN + hf * 512 + l32 * 16; n0 = *(const bf16x8*)src; n1 = *(const bf16x8*)(src + 8); }
        for (int t = c.gw; t < S; t += c.ngw) {
            const bf16x8 v0 = n0, v1 = n1; float x[16]; float ss = 0.f;
            { const int tn = t + c.ngw < S ? t + c.ngw : t; const bf16* src = PM + (size_t)tn * N_MLA_IN + hf * 512 + l32 * 16; n0 = *(const bf16x8*)src; n1 = *(const bf16x8*)(src + 8); }
#pragma unroll
            for (int e = 0; e < 8; ++e) { x[e] = bf2f((unsigned short)v0[e]); x[8 + e] = bf2f((unsigned short)v1[e]); }
#pragma unroll
            for (int e = 0; e < 16; ++e) ss += x[e] * x[e];
#pragma unroll
            for (int o = 16; o >= 1; o >>= 1) ss += __shfl_xor(ss, o);
            const float r = rsqrtf(ss * (1.f / 512.f) + EPS);
            u32x4 o0, o1;
            o0.x = pk2(x[0] * r * g[0], x[1] * r * g[1]); o0.y = pk2(x[2] * r * g[2], x[3] * r * g[3]); o0.z = pk2(x[4] * r * g[4], x[5] * r * g[5]); o0.w = pk2(x[6] * r * g[6], x[7] * r * g[7]);
            o1.x = pk2(x[8] * r * g[8], x[9] * r * g[9]); o1.y = pk2(x[10] * r * g[10], x[11] * r * g[11]); o1.z = pk2(x[12] * r * g[12], x[13] * r * g[13]); o1.w = pk2(x[14] * r * g[14], x[15] * r * g[15]);
            bf16* dst = CN + (size_t)t * 1024 + hf * 512 + l32 * 16; *(u32x4*)dst = o0; *(u32x4*)(dst + 8) = o1;
        }
    }
    SEAM(4);
    if (IN(5)) {
        { pg8::EpiStoreP EP{QRAW, 3072, nullptr, nullptr}; GEMM_SITE(EP, CN, 1024, (const bf16*)(ws + WS_W_MLA_QB), 512, S, 3072, 512, 4); }
        { pg8::EpiStoreP EP{KVRAW, 4096, nullptr, nullptr}; GEMM_SITE(EP, CN + 512, 1024, (const bf16*)(ws + WS_W_MLA_KVB), 512, S, 4096, 512, 0); }
    }
    SEAM(5);
    if (IN(6)) {
        const float* gq = (const float*)a.in[I_MLA_QG]; const float* gk = (const float*)a.in[I_MLA_KG];
        const int hl = c.lane >> 3, part = c.lane & 7;
        H8G<192> Gq, Gk; h8_gain<192>(Gq, gq, part); h8_gain<192>(Gk, gk, part);
        H8R<192> nq, nk; H8C nc;
#define MLA_LOAD(IT) do { const int t_ = (IT) >> 1, h_ = ((IT) & 1) * 8 + hl; const bf16* qs_ = QRAW + (size_t)t_ * 3072 + h_ * 192 + part * 8; \
            h8_load<192>(nq, qs_, qs_ + 64); h8_load<192>(nk, PM + (size_t)t_ * N_MLA_IN + 1024 + part * 8, KVRAW + (size_t)t_ * 4096 + h_ * 256 + part * 8); h8_rope<64>(nc, R64 + t_ * 32, part); } while (0)
        MLA_LOAD(c.gw < S * 2 ? c.gw : 0);
        for (int it = c.gw; it < S * 2; it += c.ngw) { const int t = it >> 1, h = (it & 1) * 8 + hl;
            const H8R<192> aq = nq, ak = nk; const H8C ac = nc;
            { const int itn = it + c.ngw < S * 2 ? it + c.ngw : it; MLA_LOAD(itn); }
            h8_finish<192, 64, true>(aq, Qb + (size_t)t * 3072 + h * 192 + part * 8, Gq, ac, c.lane);
            h8_finish<192, 64, true>(ak, Kb + (size_t)t * 3072 + h * 192 + part * 8, Gk, ac, c.lane); }
#undef MLA_LOAD
    }
    SEAM(6);
    if (IN(7)) { fa::AttnP A{Qb, Kb, KVRAW + 128, Ob, 0.07216878364870322f * fa::LOG2E, nullptr, nullptr, nullptr, 0.f, 0.f, nullptr, nullptr}; fa::attn_phase<0, 192, fa::Strides<3072, 192, 3072, 192, 4096, 256, 0>>(A, c.lds, c.blk, c.G, c.wave); }
    SEAM(7);
    WOUT(0, 8, xin)
    FFN_PHASES(0, 9)

    WIN(11, WS_W_DSA_IN, N_DSA_IN, BO_DSA, P, 0)
    if (IN(12)) {
        const float* gq = (const float*)a.in[I_DSA_QG]; const float* gk = (const float*)a.in[I_DSA_KG]; const float* gik = (const float*)a.in[I_DSA_IKG];
        const int hl = c.lane >> 3, part = c.lane & 7;
        H8G<128> Gq, Gk; h8_gain<128>(Gq, gq, part); h8_gain<128>(Gk, gk, part); const H8G<64> G0{}; H8G<64> Gik; h8_gain<64>(Gik, gik, part);
        H8R<128> nq[2], nk[2]; H8R<64> ni[2], nik; H8C nc32, nc16; unsigned nw;
#define DSA_LOAD(T) do { const bf16* row_ = P + (size_t)(T) * N_DSA_IN; _Pragma("unroll") for (int hb = 0; hb < 2; ++hb) { const bf16* q_ = row_ + (hb * 8 + hl) * 128 + part * 8; \
            h8_load<128>(nq[hb], q_, q_ + 64); h8_load<128>(nk[hb], q_ + 2048, q_ + 2048 + 64); h8_load<64>(ni[hb], row_ + 6144 + (hb * 8 + hl) * 64 + part * 8, nullptr); } \
            h8_load<64>(nik, row_ + 7168 + part * 8, nullptr); nw = ((const unsigned short*)row_)[7232 + (c.lane & 15)]; \
            h8_rope<32>(nc32, R32 + (T) * 16, part); h8_rope<16>(nc16, R16 + (T) * 8, part); } while (0)
        DSA_LOAD(c.gw < S ? c.gw : 0);
        for (int t = c.gw; t < S; t += c.ngw) { bf16* row = P + (size_t)t * N_DSA_IN;
            H8R<128> aq[2] = {nq[0], nq[1]}, ak[2] = {nk[0], nk[1]}; H8R<64> ai[2] = {ni[0], ni[1]}; const H8R<64> aik = nik; const unsigned aw = nw; const H8C ac32 = nc32, ac16 = nc16;
            { const int tn = t + c.ngw < S ? t + c.ngw : t; DSA_LOAD(tn); }
#pragma unroll
            for (int hb = 0; hb < 2; ++hb) { bf16* q = row + (hb * 8 + hl) * 128 + part * 8; bf16* k = q + 2048; bf16* iq = row + 6144 + (hb * 8 + hl) * 64 + part * 8;
                h8_finish<128, 32, true>(aq[hb], q, Gq, ac32, c.lane);
                h8_finish<128, 32, true>(ak[hb], k, Gk, ac32, c.lane);
                h8_finish<64, 16, false>(ai[hb], iq, G0, ac16, c.lane); }
            h8_finish<64, 16, true>(aik, c.lane < 8 ? row + 7168 + part * 8 : (bf16*)(ws + WS_O1) + c.lane * 8, Gik, ac16, c.lane);
            if (c.lane < 16) IW[t * 16 + c.lane] = bf2f(aw) * 0.25f; }
#undef DSA_LOAD
    }
    SEAM(12);
    if (IN(13)) score_mfma(P, IW, SIDX, c);
    SEAM(13);
    if (IN(14)) select_phase(SIDX, MASK, c);
    SEAM(14);
    if (IN(15)) { fa::AttnP A{P, P + 2048, P + 4096, Ob, 0.08838834764831845f * fa::LOG2E, MASK, nullptr, nullptr, 0.f, 0.f, nullptr, nullptr}; fa::attn_phase<1, 128, fa::Strides<N_DSA_IN, 128, N_DSA_IN, 128, N_DSA_IN, 128, 0>>(A, c.lds, c.blk, c.G, c.wave); }
    SEAM(15);
    WOUT(1, 16, out)
    FFN_PHASES(1, 17)

    WIN(19, WS_W_DIFF_IN, N_DIFF_IN, BO_DIFF, P, 0)
    if (IN(20)) {
        const float* gq = (const float*)a.in[I_DIFF_QG]; const float* gk = (const float*)a.in[I_DIFF_KG];
        const int hl = c.lane >> 3, part = c.lane & 7;
        H8G<64> Gq, Gk; h8_gain<64>(Gq, gq, part); h8_gain<64>(Gk, gk, part);
        H8R<64> nq[4], nk[4]; H8C nc;
#define DIFF_LOAD(T) do { const bf16* row_ = P + (size_t)(T) * N_DIFF_IN; _Pragma("unroll") for (int hb = 0; hb < 4; ++hb) { const bf16* q_ = row_ + (hb * 8 + hl) * 64 + part * 8; \
            h8_load<64>(nq[hb], q_, nullptr); h8_load<64>(nk[hb], q_ + 2048, nullptr); } h8_rope<16>(nc, R16 + (T) * 8, part); } while (0)
        DIFF_LOAD(c.gw < S ? c.gw : 0);
        for (int t = c.gw; t < S; t += c.ngw) { bf16* row = P + (size_t)t * N_DIFF_IN;
            H8R<64> aq[4] = {nq[0], nq[1], nq[2], nq[3]}, ak[4] = {nk[0], nk[1], nk[2], nk[3]}; const H8C ac = nc;
            { const int tn = t + c.ngw < S ? t + c.ngw : t; DIFF_LOAD(tn); }
#pragma unroll
            for (int hb = 0; hb < 4; ++hb) { bf16* q = row + (hb * 8 + hl) * 64 + part * 8; bf16* k = q + 2048;
                h8_finish<64, 16, true>(aq[hb], q, Gq, ac, c.lane);
                h8_finish<64, 16, true>(ak[hb], k, Gk, ac, c.lane); } }
#undef DIFF_LOAD
    }
    SEAM(20);
    if (IN(21)) {
        const float* lq1 = (const float*)a.in[I_DIFF_LQ1]; const float* lk1 = (const float*)a.in[I_DIFF_LK1];
        const float* lq2 = (const float*)a.in[I_DIFF_LQ2]; const float* lk2 = (const float*)a.in[I_DIFF_LK2];
        float d1 = 0.f, d2 = 0.f;
        for (int i = 0; i < 64; ++i) { d1 += lq1[i] * lk1[i]; d2 += lq2[i] * lk2[i]; }
        const float lam_init = 0.8f - 0.6f * 0.5488116360940264f;
        const float lam = __expf(d1) - __expf(d2) + lam_init;
        fa::AttnP A{P, P + 2048, P + 4096, Ob, 0.125f * fa::LOG2E, nullptr, nullptr, nullptr, lam, 1.f - lam_init, (const float*)a.in[I_DIFF_SUBG], (float*)(ws + WS_O1)};
        fa::attn_phase<2, 64, fa::Strides<N_DIFF_IN, 64, N_DIFF_IN, 64, N_DIFF_IN, 128, 0>>(A, c.lds, c.blk, c.G, c.wave);
    }
    SEAM(21);
    WOUT(2, 22, out)
    FFN_PHASES(2, 23)

    WIN(25, WS_W_FOX_IN, N_FOX_IN, BO_FOX, P, 1)
    if (IN(26)) {
        const float* gq = (const float*)a.in[I_FOX_QG]; const float* gk = (const float*)a.in[I_FOX_KG]; const float* bfv = (const float*)a.in[I_FOX_BF];
        const int hl = c.lane >> 3, part = c.lane & 7;
        H8G<128> Gq, Gk; h8_gain<128>(Gq, gq, part); h8_gain<128>(Gk, gk, part); const H8C C0{};
        H8R<128> nq[2], nk[2]; unsigned nz;
#define FOX_LOAD(T) do { const bf16* row_ = P + (size_t)(T) * N_FOX_IN; _Pragma("unroll") for (int hb = 0; hb < 2; ++hb) { const bf16* q_ = row_ + (hb * 8 + hl) * 128 + part * 8; \
            h8_load<128>(nq[hb], q_, q_ + 64); h8_load<128>(nk[hb], q_ + 2048, q_ + 2048 + 64); } nz = ((const unsigned short*)row_)[8192 + (c.lane & 15)]; } while (0)
        FOX_LOAD(c.gw < S ? c.gw : 0);
        for (int t = c.gw; t < S; t += c.ngw) { bf16* row = P + (size_t)t * N_FOX_IN;
            H8R<128> aq[2] = {nq[0], nq[1]}, ak[2] = {nk[0], nk[1]}; const unsigned az = nz;
            { const int tn = t + c.ngw < S ? t + c.ngw : t; FOX_LOAD(tn); }
#pragma unroll
            for (int hb = 0; hb < 2; ++hb) { bf16* q = row + (hb * 8 + hl) * 128 + part * 8; bf16* k = q + 2048;
                h8_finish<128, 0, true>(aq[hb], q, Gq, C0, c.lane);
                h8_finish<128, 0, true>(ak[hb], k, Gk, C0, c.lane); }
            if (c.lane < 16) { const float z = bf2f(az) + bfv[c.lane];
                LOGF[(size_t)c.lane * S + t] = z >= 0.f ? -log1pf(__expf(-z)) : z - log1pf(__expf(z)); } }
#undef FOX_LOAD
    }
    SEAM(26);
    if (IN(27)) ph_cumsum(LOGF, (float*)(ws + WS_CUM), c);
    SEAM(27);
    if (IN(28)) { fa::AttnP A{P, P + 2048, P + 4096, Ob, 0.08838834764831845f * fa::LOG2E, nullptr, (const float*)(ws + WS_CUM), P + 6144, 0.f, 0.f, nullptr, nullptr}; fa::attn_phase<3, 128, fa::Strides<N_FOX_IN, 128, N_FOX_IN, 128, N_FOX_IN, 128, N_FOX_IN>>(A, c.lds, c.blk, c.G, c.wave); }
    SEAM(28);
    WOUT(3, 29, out)
    FFN_PHASES(3, 30)
#undef IN
#undef SEAM
#undef mod
#undef XB
#undef P
#undef Ob
#undef HID
#undef STAT
#undef BIAS
#undef BIASP
#undef xin
#undef out
#undef R64
#undef R32
#undef R16
#undef PM
#undef CN
#undef QRAW
#undef KVRAW
#undef Qb
#undef Kb
#undef IW
#undef SIDX
#undef MASK
#undef LOGF
}

extern "C" void kernel_launch(void* const* d_in, const int* in_sizes, int n_in, void* d_out, int out_size, void* d_ws, size_t ws_size, hipStream_t stream) {
    static int grid = 0;
    if (grid == 0) {
        if (n_in != N_IN || out_size != S * D || ws_size < WS_END) { fprintf(stderr, "kernel_launch: unexpected shapes: n_in %d out %d ws %zu (need %zu)\n", n_in, out_size, ws_size, (size_t)WS_END); grid = -1; return; }
        int dev = 0, cus = 0;
        if (hipGetDevice(&dev) != hipSuccess || hipDeviceGetAttribute(&cus, hipDeviceAttributeMultiprocessorCount, dev) != hipSuccess) { grid = -1; return; }
        if (hipFuncSetAttribute((const void*)mega, hipFuncAttributeMaxDynamicSharedMemorySize, LDS_BYTES) != hipSuccess) { fprintf(stderr, "kernel_launch: hipFuncSetAttribute failed\n"); grid = -1; return; }
        int per_cu = 0;
        if (hipOccupancyMaxActiveBlocksPerMultiprocessor(&per_cu, (const void*)mega, 512, LDS_BYTES) != hipSuccess || per_cu < 1) fprintf(stderr, "kernel_launch: occupancy query says %d\n", per_cu);
        (void)hipGetLastError();
        grid = cus;
    }
    if (grid < 0) return;
    (void)hipMemsetAsync((char*)d_ws + WS_CTL, 0, CTL_ZERO_BYTES, stream);
    Args a{};
    for (int i = 0; i < N_IN; ++i) a.in[i] = d_in[i];
    a.out = (float*)d_out; a.ws = (unsigned char*)d_ws;
#if MK_PER_PHASE
    for (int p = 0; p < NPHASE; ++p) { a.ph_lo = p; a.ph_hi = p + 1; hipLaunchKernelGGL(mega, dim3(grid), dim3(512), LDS_BYTES, stream, a); }
#else
    a.ph_lo = 0; a.ph_hi = NPHASE; hipLaunchKernelGGL(mega, dim3(grid), dim3(512), LDS_BYTES, stream, a);
#endif
}
```
